# Optimizing an MI355X kernel written in HIP

```python
import math
import jax, jax.numpy as jnp
from jax import lax
import numpy as np

D_MODEL = 2048
BATCH = 2
SEQ = 16384
DEPTH = 2

CHUNK = 64
Q_BLOCK = 128
HEAD_DIM = 64
D_MIX = D_MODEL
N_GROUPS = 4
GROUP_W = D_MIX // N_GROUPS
SB_HEADS = GROUP_W // HEAD_DIM
SB_WINDOW = 1024
DIFF_HEADS = GROUP_W // (2 * HEAD_DIM)
DIFF_WINDOW = 1024
LRU_BLOCKS = 8
LRU_BW = GROUP_W // LRU_BLOCKS
LRU_C = 8.0
LRU_CONV = 4
SC_CONV = 3
D_FF = 2 * D_MODEL
FFN_CONV = 3
N_BUCKETS = 32
MAX_DISTANCE = 128
N_IN_BLOCKS = 11
IN_COLS = N_IN_BLOCKS * GROUP_W
NORM_EPS = 1e-6
NEG_INF = -1e30

kernel_name = "hybrid_parallel_group_stream_encoder"


def rms_norm(x, g):
    xf = x.astype(jnp.float32)
    y = xf * lax.rsqrt(jnp.mean(xf * xf, axis=-1, keepdims=True) + NORM_EPS)
    return (y * g.astype(jnp.float32)).astype(x.dtype)


def causal_dwconv(x, w):
    K = w.shape[0]
    S = x.shape[1]
    xp = jnp.pad(x, ((0, 0), (K - 1, 0), (0, 0)))
    y = xp[:, 0:S] * w[0]
    for k in range(1, K):
        y = y + xp[:, k:k + S] * w[k]
    return y


def t5_bucket(rel):
    nb = N_BUCKETS // 2
    max_exact = nb // 2
    ret = jnp.where(rel > 0, nb, 0)
    n = jnp.abs(rel)
    large = max_exact + (jnp.log(jnp.maximum(n, 1).astype(jnp.float32) / max_exact)
                         / math.log(MAX_DISTANCE / max_exact) * (nb - max_exact)).astype(jnp.int32)
    large = jnp.minimum(large, nb - 1)
    return ret + jnp.where(n < max_exact, n, large)


def stick_breaking_attention(q, k, v):
    Bsz, H, S, d = q.shape
    nb = S // Q_BLOCK
    span = SB_WINDOW + Q_BLOCK
    nkb = span // Q_BLOCK
    scale = d ** -0.5
    kp = jnp.pad(k, ((0, 0), (0, 0), (SB_WINDOW, 0), (0, 0)))
    vp = jnp.pad(v, ((0, 0), (0, 0), (SB_WINDOW, 0), (0, 0)))
    rel = (jnp.arange(span) - SB_WINDOW)[None, :] - jnp.arange(Q_BLOCK)[:, None]
    band = (rel < 0) & (rel >= -SB_WINDOW)
    tri = (jnp.arange(Q_BLOCK)[:, None] > jnp.arange(Q_BLOCK)[None, :]).astype(jnp.float32)
    qb = q.reshape(Bsz, H, nb, Q_BLOCK, d).transpose(2, 0, 1, 3, 4)

    def block(args):
        qi, i = args
        ki = lax.dynamic_slice_in_dim(kp, i * Q_BLOCK, span, axis=2)
        vi = lax.dynamic_slice_in_dim(vp, i * Q_BLOCK, span, axis=2)
        kpos = i * Q_BLOCK - SB_WINDOW + jnp.arange(span)
        allowed = band & (kpos >= 0)[None, :]
        z = jnp.einsum('bhqd,bhkd->bhqk', qi, ki).astype(jnp.float32) * scale
        log_keep = jnp.where(allowed, jax.nn.log_sigmoid(-z), 0.0)
        lk = log_keep.reshape(Bsz, H, Q_BLOCK, nkb, Q_BLOCK)
        within = jnp.einsum('bhqnj,js->bhqns', lk, tri)
        tot = jnp.sum(lk, axis=-1)
        later_blocks = lax.cumsum(tot, axis=3, reverse=True) - tot
        after = (within + later_blocks[..., None]).reshape(Bsz, H, Q_BLOCK, span)
        w = jnp.where(allowed, jnp.exp(jax.nn.log_sigmoid(z) + after), 0.0)
        return jnp.einsum('bhqk,bhkd->bhqd', w.astype(vi.dtype), vi)

    out = lax.map(block, (qb, jnp.arange(nb)))
    return out.transpose(1, 2, 0, 3, 4).reshape(Bsz, H, S, d)


def differential_attention(q, k, v, rel_bias, lam, subln_g, lam_init):
    Bsz, H, _, S, d = q.shape
    nb = S // Q_BLOCK
    span = DIFF_WINDOW + Q_BLOCK
    scale = d ** -0.5
    kp = jnp.pad(k, ((0, 0), (0, 0), (0, 0), (DIFF_WINDOW, 0), (0, 0)))
    vp = jnp.pad(v, ((0, 0), (0, 0), (DIFF_WINDOW, 0), (0, 0)))
    a_key = jnp.arange(span) - DIFF_WINDOW
    a_qry = jnp.arange(Q_BLOCK)
    rel = a_key[None, :] - a_qry[:, None]
    bias = rel_bias.astype(jnp.float32)[t5_bucket(rel)]
    bias = bias.transpose(2, 0, 1)[None, :, None]
    kc = (a_key // CHUNK)[None, :]
    qc = (a_qry // CHUNK)[:, None]
    band = (kc <= qc) & (kc >= qc - DIFF_WINDOW // CHUNK)
    qb = q.reshape(Bsz, H, 2, nb, Q_BLOCK, d).transpose(3, 0, 1, 2, 4, 5)

    def block(args):
        qi, i = args
        ki = lax.dynamic_slice_in_dim(kp, i * Q_BLOCK, span, axis=3)
        vi = lax.dynamic_slice_in_dim(vp, i * Q_BLOCK, span, axis=2)
        kpos = i * Q_BLOCK - DIFF_WINDOW + jnp.arange(span)
        allowed = band & (kpos >= 0)[None, :]
        logits = jnp.einsum('bhmqd,bhmkd->bhmqk', qi, ki).astype(jnp.float32) * scale
        p = jax.nn.softmax(jnp.where(allowed, logits + bias, NEG_INF), axis=-1)
        attn = p[:, :, 0] - lam * p[:, :, 1]
        return jnp.einsum('bhqk,bhke->bhqe', attn.astype(vi.dtype), vi)

    out = lax.map(block, (qb, jnp.arange(nb)))
    out = out.transpose(1, 2, 0, 3, 4).reshape(Bsz, H, S, 2 * d)
    return rms_norm(out, subln_g) * (1.0 - lam_init)


def rg_lru_branch(xb, gate, conv_w, conv_b, w_gate, b_gate, lam):
    Bsz, S, W = xb.shape
    xc = (causal_dwconv(xb, conv_w) + conv_b).astype(jnp.float32)
    xblk = xc.reshape(Bsz, S, LRU_BLOCKS, LRU_BW)
    g = jnp.einsum('bsnc,gncd->gbsnd', xblk, w_gate.astype(jnp.float32)).reshape(2, Bsz, S, W)
    g = jax.nn.sigmoid(g + b_gate.astype(jnp.float32)[:, None, None, :])
    r, i = g[0], g[1]
    log_a = -LRU_C * r * jax.nn.softplus(-lam.astype(jnp.float32))
    a = jnp.exp(log_a)
    b = jnp.sqrt(-jnp.expm1(2.0 * log_a)) * (i * xc)

    def combine(left, right):
        a1, b1 = left
        a2, b2 = right
        return a1 * a2, a2 * b1 + b2

    _, h = lax.associative_scan(combine, (a, b), axis=1)
    return (h * jax.nn.gelu(gate.astype(jnp.float32), approximate=True)).astype(xb.dtype)


def conv_geglu_ffn(h, w_up, conv_w, w_down):
    u = causal_dwconv(h @ w_up, conv_w)
    g, up = jnp.split(u, 2, axis=-1)
    return (jax.nn.gelu(g, approximate=True) * up) @ w_down


def setup_inputs(seed: int = 0) -> dict:
    key = jax.random.key(seed)
    ks = jax.random.split(key, 17)
    f32 = jnp.float32
    nrm = lambda k, s: jax.random.normal(k, s, dtype=f32)
    u = jax.random.uniform(ks[11], (DEPTH, GROUP_W), dtype=f32, minval=0.9, maxval=0.999)
    a0 = u ** (1.0 / LRU_C)
    return {
        "x": nrm(ks[0], (BATCH, SEQ, D_MODEL)),
        "norm_gains": 1.0 + 0.01 * nrm(ks[1], (DEPTH, 4, D_MODEL)),
        "w_in": nrm(ks[2], (DEPTH, D_MODEL, IN_COLS)) * D_MODEL ** -0.5,
        "w_out": nrm(ks[3], (DEPTH, D_MIX, D_MODEL)) * D_MIX ** -0.5,
        "rel_bias": 0.5 * nrm(ks[4], (N_BUCKETS, DIFF_HEADS)),
        "diff_lambda": 0.1 * nrm(ks[5], (DEPTH, 4, HEAD_DIM)),
        "diff_subln_g": 1.0 + 0.01 * nrm(ks[6], (DEPTH, 2 * HEAD_DIM)),
        "lru_conv_w": nrm(ks[7], (DEPTH, LRU_CONV, GROUP_W)) * LRU_CONV ** -0.5,
        "lru_conv_b": 0.01 * nrm(ks[8], (DEPTH, GROUP_W)),
        "lru_w_gate": nrm(ks[9], (DEPTH, 2, LRU_BLOCKS, LRU_BW, LRU_BW)) * LRU_BW ** -0.5,
        "lru_b_gate": 0.01 * nrm(ks[10], (DEPTH, 2, GROUP_W)),
        "lru_lambda": jnp.log(a0) - jnp.log1p(-a0),
        "sc_conv_w": nrm(ks[12], (DEPTH, SC_CONV, GROUP_W)) * SC_CONV ** -0.5,
        "ffn_w_up": nrm(ks[13], (DEPTH, D_MODEL, 2 * D_FF)) * D_MODEL ** -0.5,
        "ffn_conv_w": nrm(ks[14], (DEPTH, FFN_CONV, 2 * D_FF)) * FFN_CONV ** -0.5,
        "ffn_w_down": nrm(ks[15], (DEPTH, D_FF, D_MODEL)) * D_FF ** -0.5,
    }


def reference(x, norm_gains, w_in, w_out, rel_bias, diff_lambda, diff_subln_g,
              lru_conv_w, lru_conv_b, lru_w_gate, lru_b_gate, lru_lambda,
              sc_conv_w, ffn_w_up, ffn_conv_w, ffn_w_down):
    Bsz, S, _ = x.shape
    for l in range(DEPTH):
        lam_init = 0.8 - 0.6 * math.exp(-0.3 * l)
        h = rms_norm(x, norm_gains[l, 0])
        (sb_q, sb_k, sb_v, df_q, df_k, df_v,
         lru_x, lru_g, sc_b, sc_c, sc_x) = jnp.split(h @ w_in[l], N_IN_BLOCKS, axis=-1)

        to_heads = lambda t: t.reshape(Bsz, S, SB_HEADS, HEAD_DIM).transpose(0, 2, 1, 3)
        y_sb = stick_breaking_attention(to_heads(sb_q), to_heads(sb_k), to_heads(sb_v))
        y_sb = y_sb.transpose(0, 2, 1, 3).reshape(Bsz, S, GROUP_W)

        to_pairs = lambda t: t.reshape(Bsz, S, DIFF_HEADS, 2, HEAD_DIM).transpose(0, 2, 3, 1, 4)
        lv = diff_lambda[l].astype(jnp.float32)
        lam = jnp.exp(jnp.sum(lv[0] * lv[1])) - jnp.exp(jnp.sum(lv[2] * lv[3])) + lam_init
        dv = df_v.reshape(Bsz, S, DIFF_HEADS, 2 * HEAD_DIM).transpose(0, 2, 1, 3)
        y_df = differential_attention(to_pairs(df_q), to_pairs(df_k), dv, rel_bias, lam,
                                      diff_subln_g[l], lam_init)
        y_df = y_df.transpose(0, 2, 1, 3).reshape(Bsz, S, GROUP_W)

        y_lru = rg_lru_branch(lru_x, lru_g, lru_conv_w[l], lru_conv_b[l],
                              lru_w_gate[l], lru_b_gate[l], lru_lambda[l])

        y_sc = sc_b * causal_dwconv(sc_c * sc_x, sc_conv_w[l])

        mixed = jnp.concatenate([y_sb, y_df.astype(x.dtype), y_lru, y_sc], axis=-1) @ w_out[l]
        x = x + rms_norm(mixed, norm_gains[l, 1])
        h = rms_norm(x, norm_gains[l, 2])
        x = x + rms_norm(conv_geglu_ffn(h, ffn_w_up[l], ffn_conv_w[l], ffn_w_down[l]),
                         norm_gains[l, 3])
    return x
```

```cpp
#include <hip/hip_runtime.h>
#include <hip/hip_cooperative_groups.h>
#include <cstdio>
#include <cstdint>
namespace cg = cooperative_groups;
#include <hip/hip_runtime.h>
namespace pg8 {
#define PG8_LAS __attribute__((address_space(3)))
typedef unsigned short bf16_t;
typedef short bf16x8 __attribute__((ext_vector_type(8)));
typedef float f32x4 __attribute__((ext_vector_type(4)));
typedef unsigned u32x4 __attribute__((ext_vector_type(4)));
constexpr int BM = 256, BK = 64, HALF = 128, HTB = HALF * BK * 2  , STAGE_BYTES = 8 * HTB, NXCD = 8, WGM = 8;

__host__ __device__ __forceinline__ int lds_byte(int r, int c) { const int st = (r >> 4) * 2 + (c >> 5), rr = r & 15, cc = c & 31, ob = rr * 64 + cc * 2; return st * 1024 + (ob ^ (((ob >> 9) & 1) << 5)); }
__host__ __device__ __forceinline__ void stage_rc(int b, int& R, int& C) { const int st = b / 1024, sb = b % 1024, swz = sb ^ (((sb >> 9) & 1) << 5); R = (st >> 1) * 16 + swz / 64; C = (st & 1) * 32 + (swz % 64) / 2; }
__host__ __device__ __forceinline__ int perm32(int rho) { const int n = rho >> 4, i = rho & 15; return 8 * (i >> 2) + 4 * n + (i & 3); }

struct Unit { int pm, pn; };
struct Gemm { const bf16_t* A; const bf16_t* Bt; int M, N, K; };

struct StaticOrder {
    int nM, nN, nwg, G, c;
    __host__ __device__ void init(int M, int N, int G_, int c_) { nM = M / BM; nN = N / BM; nwg = nM * nN; G = G_; c = c_; }
    __host__ __device__ bool next(int i, Unit& u) const {
        const long L = (long)i * G + c; if (L >= nwg) return false;
        int wgid = (int)L; { const int q = nwg / NXCD, r = nwg % NXCD, xcd = wgid % NXCD, off = wgid / NXCD; wgid = (xcd < r ? xcd * (q + 1) : r * (q + 1) + (xcd - r) * q) + off; }
        const int nig = WGM * nN, gid = wgid / nig, fm = gid * WGM, gsz = (nM - fm) < WGM ? (nM - fm) : WGM;
        u.pm = fm + ((wgid % nig) % gsz); u.pn = (wgid % nig) / gsz; return true;
    }
    __device__ __forceinline__ void a_ready(const Unit&) const {}
    __device__ __forceinline__ void done(const Unit&) const {}
};
typedef __bf16 bf16x2v __attribute__((ext_vector_type(2)));
typedef float f32x2 __attribute__((ext_vector_type(2)));
__device__ __forceinline__ unsigned pk2(float a, float b) { f32x2 v = {a, b}; return __builtin_bit_cast(unsigned, __builtin_convertvector(v, bf16x2v)); }
struct EpiBf16 {
    static constexpr bool PERM = true, AFTER_DRAIN = false;
    bf16_t* O; int ldc; int nt;
    __device__ __forceinline__ void operator()(const f32x4 (&acc)[2][2][4][2], const Unit& u, int wr, int wc, int fr, int fq) const {
        const int row0 = u.pm * BM + wr * 64 + fr, col0 = u.pn * BM + wc * 32 + 8 * fq;
        const bool ntu = (nt == 1) || (nt == 2 && !((u.pn >= 2 && u.pn < 6) || (u.pn >= 8 && u.pn < 12)));
#pragma unroll
        for (int ai = 0; ai < 2; ++ai)
#pragma unroll
            for (int m = 0; m < 4; ++m) { bf16_t* rowp = O + (size_t)(row0 + ai * HALF + m * 16) * ldc + col0;
#pragma unroll
                for (int bj = 0; bj < 2; ++bj) { const f32x4 v0 = acc[ai][bj][m][0], v1 = acc[ai][bj][m][1];
                    u32x4 w; w.x = pk2(v0[0], v0[1]); w.y = pk2(v0[2], v0[3]); w.z = pk2(v1[0], v1[1]); w.w = pk2(v1[2], v1[3]);
                    if (ntu) __builtin_nontemporal_store(w, (u32x4*)(rowp + bj * HALF)); else *(u32x4*)(rowp + bj * HALF) = w; } }
    }
};

__device__ __forceinline__ float dpp_f(float oldv, float src, const int ctrl_sel) {
    const int o = __builtin_bit_cast(int, oldv), s = __builtin_bit_cast(int, src); int r;
    if (ctrl_sel == 0) r = __builtin_amdgcn_update_dpp(o, s, 0x121, 0xf, 0xf, true);
    else if (ctrl_sel == 1) r = __builtin_amdgcn_update_dpp(o, s, 0x122, 0xf, 0xf, true);
    else if (ctrl_sel == 2) r = __builtin_amdgcn_update_dpp(o, s, 0x111, 0xf, 0xf, false);
    else r = __builtin_amdgcn_update_dpp(o, s, 0x112, 0xf, 0xf, false);
    return __builtin_bit_cast(float, r);
}
__device__ __forceinline__ float gelu_tanh_e(float x) { const float tt = (x * x) * -1.0294323958e-01f + -2.3022081981e+00f; return x * __builtin_amdgcn_rcpf(1.f + __builtin_amdgcn_exp2f(x * tt)); }
struct EpiGeglu {
    static constexpr bool PERM = true, AFTER_DRAIN = false;
    bf16_t* Ao; bf16_t* Uh; const float* cw;
    __device__ __forceinline__ void operator()(const f32x4 (&acc)[2][2][4][2], const Unit& u, int wr, int wc, int fr, int fq) const {
        const int ch0 = u.pn * 128 + wc * 32 + 8 * fq;
        f32x4 wg[3][2], wu[3][2];
#pragma unroll
        for (int k = 0; k < 3; ++k)
#pragma unroll
            for (int n = 0; n < 2; ++n) { wg[k][n] = *(const f32x4*)(cw + k * 8192 + ch0 + 4 * n); wu[k][n] = *(const f32x4*)(cw + k * 8192 + 4096 + ch0 + 4 * n); }
#pragma unroll
        for (int ai = 0; ai < 2; ++ai) {
            const int strip = u.pm * 4 + ai * 2 + wr;
            f32x4 pg[2], pu[2];
#pragma unroll
            for (int n = 0; n < 2; ++n) { pg[n] = (f32x4){0.f, 0.f, 0.f, 0.f}; pu[n] = (f32x4){0.f, 0.f, 0.f, 0.f}; }
#pragma unroll
            for (int m = 0; m < 4; ++m) {
                f32x4 o[2];
#pragma unroll
                for (int n = 0; n < 2; ++n) { const f32x4 g = acc[ai][0][m][n], up = acc[ai][1][m][n];
#pragma unroll
                    for (int e = 0; e < 4; ++e) {
                        const float g1 = dpp_f(dpp_f(0.f, pg[n][e], 0), g[e], 2), g2 = dpp_f(dpp_f(0.f, pg[n][e], 1), g[e], 3);
                        const float u1 = dpp_f(dpp_f(0.f, pu[n][e], 0), up[e], 2), u2 = dpp_f(dpp_f(0.f, pu[n][e], 1), up[e], 3);
                        const float cg = wg[0][n][e] * g2 + wg[1][n][e] * g1 + wg[2][n][e] * g[e], cu = wu[0][n][e] * u2 + wu[1][n][e] * u1 + wu[2][n][e] * up[e];
                        o[n][e] = gelu_tanh_e(cg) * cu; }
                    pg[n] = g; pu[n] = up; }
                const int row = strip * 64 + 16 * m + fr;
                if (!(m == 0 && fr < 2)) { u32x4 w; w.x = pk2(o[0][0], o[0][1]); w.y = pk2(o[0][2], o[0][3]); w.z = pk2(o[1][0], o[1][1]); w.w = pk2(o[1][2], o[1][3]);
                    *(u32x4*)(Ao + (size_t)row * 4096 + ch0) = w; }
                if ((m == 0 && fr < 2) || (m == 3 && fr >= 14)) { const int slot = (m == 0) ? fr : fr - 12; bf16_t* hp = Uh + ((size_t)strip * 4 + slot) * 8192 + ch0;
                    const f32x4 g0 = acc[ai][0][m][0], g1v = acc[ai][0][m][1], u0 = acc[ai][1][m][0], u1v = acc[ai][1][m][1]; u32x4 w;
                    w.x = pk2(g0[0], g0[1]); w.y = pk2(g0[2], g0[3]); w.z = pk2(g1v[0], g1v[1]); w.w = pk2(g1v[2], g1v[3]); *(u32x4*)hp = w;
                    w.x = pk2(u0[0], u0[1]); w.y = pk2(u0[2], u0[3]); w.z = pk2(u1v[0], u1v[1]); w.w = pk2(u1v[2], u1v[3]); *(u32x4*)(hp + 4096) = w; }
            }
        }
    }
};

template <class Epi, class Sched, bool ALIGN_EPI = false, bool SP2 = false>
__device__ __forceinline__ void gemm_phase(PG8_LAS unsigned char* lds, const Gemm g, const Sched& S, const Epi& E) {
    int tid_ = threadIdx.x; asm volatile("" : "+v"(tid_)); const int tid = tid_, wid = __builtin_amdgcn_readfirstlane(tid >> 6), lane = tid & 63, wr = wid >> 2, wc = wid & 3, fr = lane & 15, fq = lane >> 4;
    const int K = g.K, nt = K / BK;
    unsigned voffA[2], voffB[2];
#pragma unroll
    for (int i = 0; i < 2; ++i) { int R, C; stage_rc(tid * 16 + i * 8192, R, C); const int Rb = Epi::PERM ? ((R & ~31) + perm32(R & 31)) : R;
        voffA[i] = (unsigned)(R * K + C) * 2u; voffB[i] = (unsigned)(Rb * K + C) * 2u; }
    const size_t kstep = (size_t)(BK * 2);
    const size_t hstep = (size_t)HALF * K * 2;
    const size_t tstep = 2 * hstep;
    const unsigned ldsw = (unsigned)wid * 1024u;
    const int aoff = lds_byte(wr * 64 + fr, fq * 8), boff = lds_byte(wc * 32 + fr, fq * 8);
#define PG8_SA(b, h) (((b) * 2 + (h)) * HTB)
#define PG8_SB(b, h) ((4 + (b) * 2 + (h)) * HTB)
#define PG8_STAGE(bufoff, gbase, voff) do { _Pragma("unroll") for (int _i = 0; _i < 2; ++_i) \
        __builtin_amdgcn_global_load_lds((const unsigned*)((const char*)(gbase) + (voff)[_i]), (PG8_LAS unsigned*)(lds + (bufoff) + ldsw + _i * 8192), 16, 0, 0); } while (0)
#define PG8_LDA(dst, b, h) do { _Pragma("unroll") for (int m = 0; m < 4; ++m) _Pragma("unroll") for (int k = 0; k < 2; ++k) dst[m][k] = *(const PG8_LAS bf16x8*)(lds + PG8_SA(b, h) + aoff + m * 2048 + k * 1024); } while (0)
#define PG8_LDB(dst, b, h) do { _Pragma("unroll") for (int n = 0; n < 2; ++n) _Pragma("unroll") for (int k = 0; k < 2; ++k) dst[n][k] = *(const PG8_LAS bf16x8*)(lds + PG8_SB(b, h) + boff + n * 2048 + k * 1024); } while (0)
#define PG8_MMA(ai, bj, At, Bt) do { __builtin_amdgcn_s_setprio(1); _Pragma("unroll") for (int m = 0; m < 4; ++m) _Pragma("unroll") for (int n = 0; n < 2; ++n) _Pragma("unroll") for (int k = 0; k < 2; ++k) \
        acc[ai][bj][m][n] = __builtin_amdgcn_mfma_f32_16x16x32_bf16(Bt[n][k], At[m][k], acc[ai][bj][m][n], 0, 0, 0); __builtin_amdgcn_s_setprio(0); } while (0)
#define PG8_WAIT_V(n) asm volatile("s_waitcnt vmcnt(" #n ")" ::: "memory")
#define PG8_WAIT_L(n) asm volatile("s_waitcnt lgkmcnt(" #n ")" ::: "memory")
#define PG8_BAR __builtin_amdgcn_s_barrier()
#define PG8_SCHED __builtin_amdgcn_sched_barrier(0)
    Unit cur, nxt; int ui = 0;
    if (!S.next(0, cur)) return;
    f32x4 acc[2][2][4][2];
#pragma unroll
    for (int a = 0; a < 2; ++a)
#pragma unroll
        for (int b = 0; b < 2; ++b)
#pragma unroll
            for (int m = 0; m < 4; ++m)
#pragma unroll
                for (int n = 0; n < 2; ++n) acc[a][b][m][n] = (f32x4){0.f, 0.f, 0.f, 0.f};
    bf16x8 At[4][2], B0[2][2], B1[2][2];
    const char* cA = (const char*)g.A + (size_t)cur.pm * tstep; const char* cB = (const char*)g.Bt + (size_t)cur.pn * tstep;
    S.a_ready(cur);
    if constexpr (SP2) {
        PG8_STAGE(PG8_SB(0, 0), cB, voffB); PG8_STAGE(PG8_SB(0, 1), cB + hstep, voffB); PG8_STAGE(PG8_SA(0, 0), cA, voffA); PG8_STAGE(PG8_SA(0, 1), cA + hstep, voffA);
        if (wr == 1) PG8_BAR;
        PG8_WAIT_V(2); PG8_BAR;
        PG8_STAGE(PG8_SB(1, 0), cB + kstep, voffB); PG8_STAGE(PG8_SA(1, 0), cA + kstep, voffA); PG8_STAGE(PG8_SB(1, 1), cB + hstep + kstep, voffB);
        PG8_WAIT_V(6); PG8_BAR;
    } else {
        PG8_STAGE(PG8_SB(0, 0), cB, voffB); PG8_STAGE(PG8_SA(0, 0), cA, voffA); PG8_STAGE(PG8_SB(0, 1), cB + hstep, voffB); PG8_STAGE(PG8_SA(0, 1), cA + hstep, voffA);
        if (wr == 1) PG8_BAR;
        PG8_WAIT_V(4); PG8_BAR;
        PG8_STAGE(PG8_SB(1, 0), cB + kstep, voffB); PG8_STAGE(PG8_SA(1, 0), cA + kstep, voffA); PG8_STAGE(PG8_SB(1, 1), cB + hstep + kstep, voffB);
        PG8_WAIT_V(6); PG8_BAR;
    }
    for (;;) {
        const bool has_next = S.next(ui + 1, nxt);
        const char* nA = has_next ? (const char*)g.A + (size_t)nxt.pm * tstep : cA; const char* nB = has_next ? (const char*)g.Bt + (size_t)nxt.pn * tstep : cB;
        for (int t = 0; t < nt; t += 2) {
            const bool last = (t == nt - 2);
            const char* a1 = cA + (size_t)(t + 1) * kstep;
            const char* a2 = last ? nA : cA + (size_t)(t + 2) * kstep; const char* b2 = last ? nB : cB + (size_t)(t + 2) * kstep;
            const char* a3 = a2 + kstep; const char* b3 = b2 + kstep;
            if (last && has_next) S.a_ready(nxt);
            if constexpr (SP2) {
            PG8_LDB(B0, 0, 0); PG8_LDB(B1, 0, 1); PG8_SCHED; PG8_LDA(At, 0, 0); PG8_STAGE(PG8_SA(1, 1), a1 + hstep, voffA);
            PG8_WAIT_V(8); PG8_WAIT_L(0); PG8_BAR; PG8_MMA(0, 0, At, B0); PG8_MMA(0, 1, At, B1); PG8_BAR; PG8_SCHED;
            PG8_LDA(At, 0, 1); PG8_STAGE(PG8_SB(0, 0), b2, voffB); PG8_STAGE(PG8_SB(0, 1), b2 + hstep, voffB); PG8_STAGE(PG8_SA(0, 0), a2, voffA);
            PG8_WAIT_V(8); PG8_WAIT_L(0); PG8_BAR; PG8_MMA(1, 0, At, B0); PG8_MMA(1, 1, At, B1); PG8_BAR; PG8_SCHED;
            PG8_LDB(B0, 1, 0); PG8_LDB(B1, 1, 1); PG8_SCHED; PG8_LDA(At, 1, 0); PG8_STAGE(PG8_SA(0, 1), a2 + hstep, voffA);
            PG8_WAIT_V(8); PG8_WAIT_L(0); PG8_BAR; PG8_MMA(0, 0, At, B0); PG8_MMA(0, 1, At, B1); PG8_BAR; PG8_SCHED;
            PG8_LDA(At, 1, 1); PG8_STAGE(PG8_SB(1, 0), b3, voffB); PG8_STAGE(PG8_SB(1, 1), b3 + hstep, voffB); PG8_STAGE(PG8_SA(1, 0), a3, voffA);
            PG8_WAIT_V(8); PG8_WAIT_L(0); PG8_BAR; PG8_MMA(1, 0, At, B0); PG8_MMA(1, 1, At, B1); PG8_BAR; PG8_SCHED;
            } else {
            PG8_LDB(B0, 0, 0); PG8_SCHED; PG8_LDA(At, 0, 0); PG8_STAGE(PG8_SA(1, 1), a1 + hstep, voffA);
            PG8_WAIT_L(8); PG8_BAR; PG8_WAIT_L(0); PG8_MMA(0, 0, At, B0); PG8_BAR; PG8_SCHED;
            PG8_LDB(B1, 0, 1); PG8_STAGE(PG8_SB(0, 0), b2, voffB);
            PG8_BAR; PG8_WAIT_L(0); PG8_MMA(0, 1, At, B1); PG8_BAR;
            PG8_LDA(At, 0, 1); PG8_STAGE(PG8_SA(0, 0), a2, voffA);
            PG8_BAR; PG8_WAIT_L(0); PG8_MMA(1, 0, At, B0); PG8_BAR; PG8_SCHED;
            PG8_STAGE(PG8_SB(0, 1), b2 + hstep, voffB);
            PG8_WAIT_V(6); PG8_BAR; PG8_MMA(1, 1, At, B1); PG8_BAR;
            PG8_LDB(B0, 1, 0); PG8_SCHED; PG8_LDA(At, 1, 0); PG8_STAGE(PG8_SA(0, 1), a2 + hstep, voffA);
            PG8_WAIT_L(8); PG8_BAR; PG8_WAIT_L(0); PG8_MMA(0, 0, At, B0); PG8_BAR; PG8_SCHED;
            PG8_LDB(B1, 1, 1); PG8_STAGE(PG8_SB(1, 0), b3, voffB);
            PG8_BAR; PG8_WAIT_L(0); PG8_MMA(0, 1, At, B1); PG8_BAR;
            PG8_LDA(At, 1, 1); PG8_STAGE(PG8_SA(1, 0), a3, voffA);
            PG8_BAR; PG8_WAIT_L(0); PG8_MMA(1, 0, At, B0); PG8_BAR; PG8_SCHED;
            PG8_STAGE(PG8_SB(1, 1), b3 + hstep, voffB);
            PG8_WAIT_V(6); PG8_BAR; PG8_MMA(1, 1, At, B1); PG8_BAR;
            }
        }
        if constexpr (ALIGN_EPI) { if (wr == 0) PG8_BAR; }
        if constexpr (!Epi::AFTER_DRAIN) { E(acc, cur, wr, wc, fr, fq); S.done(cur); }
        if (!has_next) break;
#pragma unroll
        for (int a = 0; a < 2; ++a)
#pragma unroll
            for (int b = 0; b < 2; ++b)
#pragma unroll
                for (int m = 0; m < 4; ++m)
#pragma unroll
                    for (int n = 0; n < 2; ++n) acc[a][b][m][n] = (f32x4){0.f, 0.f, 0.f, 0.f};
        cur = nxt; cA = nA; cB = nB; ++ui;
        if constexpr (ALIGN_EPI) { if (wr == 1) PG8_BAR; }
    }
    PG8_WAIT_V(0);
    if constexpr (!ALIGN_EPI) { if (wr == 0) PG8_BAR; }
    PG8_BAR;
    if constexpr (Epi::AFTER_DRAIN) { E.fused(acc, cur, wr, wc, fr, fq, lds, wid, lane); S.done(cur); }
#undef PG8_SA
#undef PG8_SB
#undef PG8_STAGE
#undef PG8_LDA
#undef PG8_LDB
#undef PG8_MMA
#undef PG8_WAIT_V
#undef PG8_WAIT_L
#undef PG8_BAR
#undef PG8_SCHED
}
}
typedef unsigned short bf16;
typedef short bf16x8 __attribute__((ext_vector_type(8)));
typedef short s16x4 __attribute__((ext_vector_type(4)));
typedef float f32x4 __attribute__((ext_vector_type(4)));
typedef float f32x16 __attribute__((ext_vector_type(16)));
typedef unsigned u32x4 __attribute__((ext_vector_type(4)));
typedef unsigned u32x2 __attribute__((ext_vector_type(2)));
#define LAS __attribute__((address_space(3)))
#define DI __device__ __forceinline__
using pg8::pk2;

constexpr int NB = 2, S = 16384, T = NB * S, D = 2048, NIN = 5632, DFF = 4096, NUP = 8192;
constexpr int C_SBQ = 0, C_SBK = 512, C_SBV = 1024, C_DFQ = 1536, C_DFK = 2048, C_DFV = 2560, C_LX = 3072, C_LG = 3584, C_SCB = 4096, C_SCC = 4608, C_SCX = 5120;
constexpr size_t MiB = 1u << 20;
constexpr size_t WS_WIN = 1 * MiB, WS_WOUT = 23 * MiB, WS_WUP = 31 * MiB, WS_WDN = 63 * MiB, WS_CAR = 79 * MiB, WS_A0 = 80 * MiB, WS_B = 208 * MiB, WS_C = 720 * MiB, WS_END = 976 * MiB;
constexpr size_t WS_Y = WS_B + 352 * MiB;
constexpr int LDS_BYTES = 147456;
constexpr int NTHREADS = 512;

struct Params {
    const float* x; const float* norm_gains; const float* w_in; const float* w_out; const float* rel_bias; const float* diff_lambda; const float* diff_subln_g;
    const float* lru_conv_w; const float* lru_conv_b; const float* lru_w_gate; const float* lru_b_gate; const float* lru_lambda; const float* sc_conv_w;
    const float* ffn_w_up; const float* ffn_conv_w; const float* ffn_w_down;
    float* out; unsigned char* ws; int ph_lo, ph_hi;
};

DI int otid() { int t = threadIdx.x; asm volatile("" : "+v"(t)); return t; }
DI float bf2f(unsigned short b) { return __uint_as_float(((unsigned)b) << 16); }
DI unsigned short f2bf(float f) { return (unsigned short)(pk2(f, 0.f) & 0xffffu); }
DI float xor32(float x) { const unsigned u = __builtin_bit_cast(unsigned, x); auto r = __builtin_amdgcn_permlane32_swap(u, u, false, false);
    return __builtin_bit_cast(float, (threadIdx.x & 32) ? (unsigned)r[0] : (unsigned)r[1]); }
DI float wave_sum(float v) {
#pragma unroll
    for (int o = 32; o >= 1; o >>= 1) v += __shfl_xor(v, o);
    return v; }
DI void unpack8(const u32x4 w, float (&v)[8]) {
    v[0] = __uint_as_float(w.x << 16); v[1] = __uint_as_float(w.x & 0xffff0000u); v[2] = __uint_as_float(w.y << 16); v[3] = __uint_as_float(w.y & 0xffff0000u);
    v[4] = __uint_as_float(w.z << 16); v[5] = __uint_as_float(w.z & 0xffff0000u); v[6] = __uint_as_float(w.w << 16); v[7] = __uint_as_float(w.w & 0xffff0000u); }
DI u32x4 pack8(const float (&v)[8]) { u32x4 w; w.x = pk2(v[0], v[1]); w.y = pk2(v[2], v[3]); w.z = pk2(v[4], v[5]); w.w = pk2(v[6], v[7]); return w; }
DI float gelu_tanh(float x) { const float tt = (x * x) * -1.0294323958e-01f + -2.3022081981e+00f; return x * __builtin_amdgcn_rcpf(1.f + __builtin_amdgcn_exp2f(x * tt)); }
DI float sigmoidf_(float x) { return __builtin_amdgcn_rcpf(1.f + __expf(-x)); }
#define MFMA32(a, b, c) __builtin_amdgcn_mfma_f32_32x32x16_bf16((a), (b), (c), 0, 0, 0)
DI s16x4 tr_read(LAS unsigned char* p) { return __builtin_amdgcn_ds_read_tr16_b64_v4i16((LAS s16x4*)p); }

DI void load_row_f32(const float* p, int lane, float (&v)[32]) {
#pragma unroll
    for (int c = 0; c < 4; ++c) { const float* q = p + (c * 64 + lane) * 8; const f32x4 a = *(const f32x4*)q, b = *(const f32x4*)(q + 4);
        v[8 * c] = a[0]; v[8 * c + 1] = a[1]; v[8 * c + 2] = a[2]; v[8 * c + 3] = a[3]; v[8 * c + 4] = b[0]; v[8 * c + 5] = b[1]; v[8 * c + 6] = b[2]; v[8 * c + 7] = b[3]; } }
DI void store_row_f32(float* p, int lane, const float (&v)[32]) {
#pragma unroll
    for (int c = 0; c < 4; ++c) { float* q = p + (c * 64 + lane) * 8; *(f32x4*)q = (f32x4){v[8 * c], v[8 * c + 1], v[8 * c + 2], v[8 * c + 3]}; *(f32x4*)(q + 4) = (f32x4){v[8 * c + 4], v[8 * c + 5], v[8 * c + 6], v[8 * c + 7]}; } }
DI void load_row_bf16(const bf16* p, int lane, float (&v)[32]) {
#pragma unroll
    for (int c = 0; c < 4; ++c) { const u32x4 w = *(const u32x4*)(p + (c * 64 + lane) * 8); float t[8]; unpack8(w, t);
#pragma unroll
        for (int j = 0; j < 8; ++j) v[8 * c + j] = t[j]; } }
DI void store_row_bf16(bf16* p, int lane, const float (&v)[32]) {
#pragma unroll
    for (int c = 0; c < 4; ++c) { u32x4 w; w.x = pk2(v[8 * c], v[8 * c + 1]); w.y = pk2(v[8 * c + 2], v[8 * c + 3]); w.z = pk2(v[8 * c + 4], v[8 * c + 5]); w.w = pk2(v[8 * c + 6], v[8 * c + 7]);
        *(u32x4*)(p + (c * 64 + lane) * 8) = w; } }

struct CvtTile { const float* src; bf16* dst; int K; };
DI bool cvt_select(const Params& p, int l, int i, CvtTile& t, int& N) {
    if (i >= 9984) return false;
    const float* W; bf16* Wt; int K, tile; bool perm = false;
    if (i < 2816) { W = p.w_in + (size_t)l * D * NIN; Wt = (bf16*)(p.ws + WS_WIN); K = D; N = NIN; tile = i; }
    else if (i < 3840) { W = p.w_out + (size_t)l * D * D; Wt = (bf16*)(p.ws + WS_WOUT); K = D; N = D; tile = i - 2816; }
    else if (i < 7936) { W = p.ffn_w_up + (size_t)l * D * NUP; Wt = (bf16*)(p.ws + WS_WUP); K = D; N = NUP; tile = i - 3840; perm = true; }
    else { W = p.ffn_w_down + (size_t)l * DFF * D; Wt = (bf16*)(p.ws + WS_WDN); K = DFF; N = D; tile = i - 7936; }
    const int ntn = N >> 6, tk = tile / ntn, tn = tile - tk * ntn, k0 = tk * 64, n0 = tn * 64;
    const int ns0 = perm ? ((tn >> 1) & 1) * 4096 + (tn >> 2) * 128 + (tn & 1) * 64 : n0;
    t.src = W + (size_t)k0 * N + ns0; t.dst = Wt + (size_t)n0 * K + k0; t.K = K; return true;
}
DI void convert_layer(const Params& p, int l, LAS unsigned char* lds) {
    const int tid = otid();
    LAS bf16* tl = (LAS bf16*)lds;
    const int kp = (tid >> 4) * 2, n4 = (tid & 15) * 4;
    const int n = tid >> 3, k8 = (tid & 7) * 8;
    CvtTile cur, nxt; int N = 0, Nn = 0;
    int i = blockIdx.x;
    bool have = cvt_select(p, l, i, cur, N);
    f32x4 v0 = (f32x4){0.f, 0.f, 0.f, 0.f}, v1 = v0;
    if (have) { v0 = *(const f32x4*)(cur.src + (size_t)kp * N + n4); v1 = *(const f32x4*)(cur.src + (size_t)(kp + 1) * N + n4); }
    while (have) {
#pragma unroll
        for (int j = 0; j < 4; ++j) *(LAS unsigned*)(tl + (n4 + j) * 72 + kp) = pk2(v0[j], v1[j]);
        i += gridDim.x;
        const bool hn = cvt_select(p, l, i, nxt, Nn);
        if (hn) { v0 = *(const f32x4*)(nxt.src + (size_t)kp * Nn + n4); v1 = *(const f32x4*)(nxt.src + (size_t)(kp + 1) * Nn + n4); }
        __syncthreads();
        const u32x4 o = *(LAS u32x4*)(tl + n * 72 + k8);
        *(u32x4*)(cur.dst + (size_t)n * cur.K + k8) = o;
        __syncthreads();
        cur = nxt; N = Nn; have = hn;
    }
}

DI void norm0_phase(const float* x, const float* g, bf16* hb) {
    const int tid = otid(), lane = tid & 63, wave = tid >> 6;
    float gv[32]; load_row_f32(g, lane, gv);
    for (int row = blockIdx.x * 8 + wave; row < T; row += gridDim.x * 8) {
        float v[32]; load_row_f32(x + (size_t)row * D, lane, v);
        float ss = 0.f;
#pragma unroll
        for (int e = 0; e < 32; ++e) ss += v[e] * v[e];
        ss = wave_sum(ss); const float r = rsqrtf(ss * (1.f / 2048.f) + 1e-6f);
#pragma unroll
        for (int e = 0; e < 32; ++e) v[e] = v[e] * r * gv[e];
        store_row_bf16(hb + (size_t)row * D, lane, v);
    }
}
template <bool INBF, bool OUTBF>
DI void normres_phase(bf16* mix, const void* xin_, void* xout_, const float* gA, const float* gB) {
    const int tid = otid(), lane = tid & 63, wave = tid >> 6;
    float ga[32], gb[32];
    load_row_f32(gA, lane, ga);
    if (gB) load_row_f32(gB, lane, gb);
    const int rstep = gridDim.x * 8;
    int row = blockIdx.x * 8 + wave;
    u32x4 rm[4]; f32x4 rx[INBF ? 1 : 8]; u32x4 rxb[INBF ? 4 : 1];
#define NR_LOAD(rw) do { _Pragma("unroll") for (int c = 0; c < 4; ++c) { rm[c] = *(const u32x4*)(mix + (size_t)(rw) * D + (c * 64 + lane) * 8); \
        if constexpr (INBF) rxb[c] = *(const u32x4*)((const bf16*)xin_ + (size_t)(rw) * D + (c * 64 + lane) * 8); \
        else { const float* q = (const float*)xin_ + (size_t)(rw) * D + (c * 64 + lane) * 8; rx[2 * c] = *(const f32x4*)q; rx[2 * c + 1] = *(const f32x4*)(q + 4); } } } while (0)
    NR_LOAD(row);
    for (; row < T; row += rstep) {
        float m[32], xv[32];
#pragma unroll
        for (int c = 0; c < 4; ++c) { float t8[8]; unpack8(rm[c], t8);
#pragma unroll
            for (int j = 0; j < 8; ++j) m[8 * c + j] = t8[j];
            if constexpr (INBF) { unpack8(rxb[c], t8);
#pragma unroll
                for (int j = 0; j < 8; ++j) xv[8 * c + j] = t8[j]; }
            else {
#pragma unroll
                for (int j = 0; j < 4; ++j) { xv[8 * c + j] = rx[2 * c][j]; xv[8 * c + 4 + j] = rx[2 * c + 1][j]; } } }
        const int nrow = row + rstep;
        if (nrow < T) NR_LOAD(nrow);
        float ss = 0.f;
#pragma unroll
        for (int e = 0; e < 32; ++e) ss += m[e] * m[e];
        ss = wave_sum(ss); const float r1 = rsqrtf(ss * (1.f / 2048.f) + 1e-6f);
#pragma unroll
        for (int e = 0; e < 32; ++e) xv[e] += m[e] * r1 * ga[e];
        if constexpr (OUTBF) store_row_bf16((bf16*)xout_ + (size_t)row * D, lane, xv); else store_row_f32((float*)xout_ + (size_t)row * D, lane, xv);
        if (gB) {
            float s2 = 0.f;
#pragma unroll
            for (int e = 0; e < 32; ++e) s2 += xv[e] * xv[e];
            s2 = wave_sum(s2); const float r2 = rsqrtf(s2 * (1.f / 2048.f) + 1e-6f);
#pragma unroll
            for (int e = 0; e < 32; ++e) m[e] = xv[e] * r2 * gb[e];
            store_row_bf16(mix + (size_t)row * D, lane, m);
        }
    }
#undef NR_LOAD
}
template <bool MASK>
DI void sb_sub(LAS unsigned char* kfs, LAS unsigned char* vts, const bf16x8 (&qf)[4], f32x16 (&O)[2], float& Rp, int kb, int q, int hh) {
    f32x16 acc;
#pragma unroll
    for (int i = 0; i < 16; ++i) acc[i] = 0.f;
#pragma unroll
    for (int ks = 0; ks < 4; ++ks) { const bf16x8 kf = *(LAS bf16x8*)(kfs + 32 * ks); acc = MFMA32(kf, qf[ks], acc); }
    float z[16], L[16];
#pragma unroll
    for (int i = 0; i < 16; ++i) { const float t = acc[i] * 0.18033688011112042f; const float e = __builtin_amdgcn_exp2f(fminf(t, 126.f)); const float l2 = fmaxf(__builtin_amdgcn_logf(1.f + e), t);
        if (MASK) { const int key = kb + (i & 3) + 8 * (i >> 2); const bool al = (key < q) && (key >= q - 1024); L[i] = al ? l2 : 0.f; z[i] = al ? t : -1e30f; }
        else { L[i] = l2; z[i] = t; } }
    float Gs[4], Gp[4];
#pragma unroll
    for (int g = 0; g < 4; ++g) { L[4 * g + 2] += L[4 * g + 3]; L[4 * g + 1] += L[4 * g + 2]; L[4 * g] += L[4 * g + 1]; Gs[g] = L[4 * g]; }
#pragma unroll
    for (int g = 0; g < 4; ++g) Gp[g] = xor32(Gs[g]);
    float run = Rp;
#pragma unroll
    for (int g = 3; g >= 0; --g) { const float off = hh ? run : run + Gp[g];
#pragma unroll
        for (int j = 0; j < 4; ++j) L[4 * g + j] += off;
        run += Gs[g] + Gp[g]; }
    Rp = run;
    float w[16];
#pragma unroll
    for (int i = 0; i < 16; ++i) w[i] = __builtin_amdgcn_exp2f(z[i] - L[i]);
#pragma unroll
    for (int s = 0; s < 2; ++s) {
        u32x4 wp; wp.x = pk2(w[8 * s], w[8 * s + 1]); wp.y = pk2(w[8 * s + 2], w[8 * s + 3]); wp.z = pk2(w[8 * s + 4], w[8 * s + 5]); wp.w = pk2(w[8 * s + 6], w[8 * s + 7]);
        const bf16x8 wf = __builtin_bit_cast(bf16x8, wp);
#pragma unroll
        for (int dt = 0; dt < 2; ++dt) {
            const s16x4 lo = tr_read(vts + (16 * s) * 192 + 64 * dt), hi = tr_read(vts + (16 * s + 8) * 192 + 64 * dt);
            const bf16x8 vf = __builtin_shufflevector(lo, hi, 0, 1, 2, 3, 4, 5, 6, 7);
            O[dt] = MFMA32(vf, wf, O[dt]); }
    }
}
DI void sb_unit(const bf16* P, bf16* Y, int unit, LAS unsigned char* lds) {
    const int tid = otid(), lane = tid & 63, wave = __builtin_amdgcn_readfirstlane(tid >> 6), r = lane & 31, hh = lane >> 5;
    const int qb = unit & 255, hg = (unit >> 8) & 1, b = unit >> 9;
    const int hl = wave >> 1, h = hg * 4 + hl, qw = qb * 64 + (wave & 1) * 32;
    const bf16* Pb = P + (size_t)b * S * NIN;
    bf16x8 qf[4];
    { const bf16* qp = Pb + (size_t)(qw + r) * NIN + C_SBQ + h * 64 + 8 * hh;
#pragma unroll
      for (int ks = 0; ks < 4; ++ks) qf[ks] = *(const bf16x8*)(qp + 16 * ks); }
    f32x16 O[2];
#pragma unroll
    for (int i = 0; i < 16; ++i) { O[0][i] = 0.f; O[1][i] = 0.f; }
    float Rp = 0.f;
    LAS unsigned char* Ks = lds + hl * 21504; LAS unsigned char* Vs = Ks + 9216; LAS unsigned* dflag = (LAS unsigned*)(lds + 86016);
    if (tid < 8) dflag[tid] = 0u;
    const int t_hi = qb; int t_lo = qb - 16; if (t_lo < 0) t_lo = 0;
    const int lrow0 = tid >> 5, lch = tid & 31;
    const bf16* kg = Pb + (size_t)lrow0 * NIN + C_SBK + hg * 256 + lch * 8; const bf16* vg = Pb + (size_t)lrow0 * NIN + C_SBV + hg * 256 + lch * 8;
    LAS unsigned char* kst = lds + (lch >> 3) * 21504 + lrow0 * 144 + (lch & 7) * 16; LAS unsigned char* vst = lds + (lch >> 3) * 21504 + 9216 + lrow0 * 192 + (lch & 7) * 16;
    u32x4 krA[4], vrA[4], krB[4], vrB[4];
#define SB_LOAD(KR, VR, tt) do { _Pragma("unroll") for (int i_ = 0; i_ < 4; ++i_) { KR[i_] = *(const u32x4*)(kg + (size_t)((tt) * 64 + 16 * i_) * NIN); VR[i_] = *(const u32x4*)(vg + (size_t)((tt) * 64 + 16 * i_) * NIN); } } while (0)
#define SB_STORE(KR, VR) do { _Pragma("unroll") for (int i_ = 0; i_ < 4; ++i_) { *(LAS u32x4*)(kst + i_ * 16 * 144) = KR[i_]; *(LAS u32x4*)(vst + i_ * 16 * 192) = VR[i_]; } } while (0)
    SB_LOAD(krA, vrA, t_hi);
    if (t_hi - 1 >= t_lo) SB_LOAD(krB, vrB, t_hi - 1);
    const int q4 = (lane & 15) >> 2, pp = lane & 3, blk = (lane >> 4) & 1;
    LAS unsigned char* vtr = Vs + (4 * hh + q4) * 192 + 32 * blk + 8 * pp;
    LAS unsigned char* kfr = Ks + r * 144 + 16 * hh;
    bool alldone = false;
    for (int tt = t_hi; tt >= t_lo && !alldone; tt -= 2) {
#pragma unroll
      for (int par = 0; par < 2; ++par) {
        const int t = tt - par;
        if (t < t_lo) break;
        __syncthreads();
        { const u32x4 f0 = *(LAS u32x4*)dflag, f1 = *(LAS u32x4*)(dflag + 4);
          if ((f0.x & f0.y & f0.z & f0.w & f1.x & f1.y & f1.z & f1.w) != 0u) { alldone = true; break; } }
        if (par == 0) SB_STORE(krA, vrA); else SB_STORE(krB, vrB);
        __syncthreads();
        if (t - 2 >= t_lo) { if (par == 0) SB_LOAD(krA, vrA, t - 2); else SB_LOAD(krB, vrB, t - 2); }
        const int k0 = t * 64;
#pragma unroll
        for (int sub = 1; sub >= 0; --sub) {
            const int ks0 = k0 + sub * 32;
            if (ks0 < qw + 31 && ks0 + 31 >= qw - 1024) {
                if (ks0 + 31 < qw && ks0 >= qw + 31 - 1024) sb_sub<false>(kfr + sub * 32 * 144, vtr + sub * 32 * 192, qf, O, Rp, ks0 + 4 * hh, qw + r, hh);
                else sb_sub<true>(kfr + sub * 32 * 144, vtr + sub * 32 * 192, qf, O, Rp, ks0 + 4 * hh, qw + r, hh);
            }
        }
        const bool fin = (__all(Rp > 160.f) != 0) || (k0 - 1 < qw - 1024);
        if (fin && lane == 0) dflag[wave] = 1u;
      }
    }
#undef SB_LOAD
#undef SB_STORE
    bf16* yp = Y + (size_t)(b * S + qw + r) * D + h * 64 + 4 * hh;
#pragma unroll
    for (int dt = 0; dt < 2; ++dt)
#pragma unroll
        for (int g = 0; g < 4; ++g) { u32x2 o; o.x = pk2(O[dt][4 * g], O[dt][4 * g + 1]); o.y = pk2(O[dt][4 * g + 2], O[dt][4 * g + 3]); *(u32x2*)(yp + 32 * dt + 8 * g) = o; }
}

DI void df_unit(const Params& p, int l, const bf16* P, bf16* Y, int unit, LAS unsigned char* lds) {
    const int tid = otid(), lane = tid & 63, wave = __builtin_amdgcn_readfirstlane(tid >> 6), r = lane & 31, hh = lane >> 5;
    const int g = wave >> 1, m = wave & 1;
    const int qb = unit & 127, hd = (unit >> 7) & 3, b = unit >> 9;
    const int q0 = qb * 128, qw = q0 + g * 32, qc = qw >> 6;
    const bf16* Pb = P + (size_t)b * S * NIN;
    LAS unsigned char* Ks = lds; LAS unsigned char* Vs = lds + 17408; LAS float* tab = (LAS float*)(lds + 37888); LAS float* exch = (LAS float*)(lds + 43008) + g * 4096;
    const float* lv = p.diff_lambda + l * 256;
    const float s01 = wave_sum(lv[lane] * lv[64 + lane]), s23 = wave_sum(lv[128 + lane] * lv[192 + lane]);
    const float lam_init = 0.8f - 0.6f * expf(-0.3f * (float)l);
    const float lam = expf(s01) - expf(s23) + lam_init;
    for (int idx = tid; idx < 1152; idx += NTHREADS) { const int rel = idx - 1087, n = rel < 0 ? -rel : rel;
        int bk = n < 8 ? n : (n < 12 ? 8 : (n < 16 ? 9 : (n < 23 ? 10 : (n < 32 ? 11 : (n < 46 ? 12 : (n < 64 ? 13 : (n < 91 ? 14 : 15)))))));
        if (rel > 0) bk += 16;
        tab[idx] = p.rel_bias[bk * 4 + hd] * 1.4426950408889634f; }
    bf16x8 qf[4];
    { const bf16* qp = Pb + (size_t)(qw + r) * NIN + C_DFQ + hd * 128 + m * 64 + 8 * hh;
#pragma unroll
      for (int ks = 0; ks < 4; ++ks) qf[ks] = *(const bf16x8*)(qp + 16 * ks); }
    const int t_hi = (q0 >> 6) + 1; int t_lo = (q0 >> 6) - 16; if (t_lo < 0) t_lo = 0;
    const int lrow0 = tid >> 4, lch = tid & 15;
    const bf16* kg = Pb + (size_t)lrow0 * NIN + C_DFK + hd * 128 + lch * 8; const bf16* vg = Pb + (size_t)lrow0 * NIN + C_DFV + hd * 128 + lch * 8;
    LAS unsigned char* kst = Ks + lrow0 * 272 + lch * 16; LAS unsigned char* vst = Vs + lrow0 * 320 + lch * 16;
    LAS unsigned char* kfr = Ks + r * 272 + 16 * hh + m * 128;
    const int q4 = (lane & 15) >> 2, pp = lane & 3, blk = (lane >> 4) & 1;
    LAS unsigned char* vtr = Vs + (4 * hh + q4) * 320 + 32 * blk + 8 * pp;
    const int tb0 = 4 * hh - (qw + r) + 1087;
    float mrun = -1e30f, lsum = 0.f;
    f32x16 O[4];
#pragma unroll
    for (int dt = 0; dt < 4; ++dt)
#pragma unroll
        for (int i = 0; i < 16; ++i) O[dt][i] = 0.f;
    u32x4 krA[2], vrA[2], krB[2], vrB[2], krC[2], vrC[2];
#define DF_LOAD(KR, VR, tt) do { _Pragma("unroll") for (int i_ = 0; i_ < 2; ++i_) { KR[i_] = *(const u32x4*)(kg + (size_t)((tt) * 64 + 32 * i_) * NIN); VR[i_] = *(const u32x4*)(vg + (size_t)((tt) * 64 + 32 * i_) * NIN); } } while (0)
#define DF_STORE(KR, VR) do { _Pragma("unroll") for (int i_ = 0; i_ < 2; ++i_) { *(LAS u32x4*)(kst + i_ * 32 * 272) = KR[i_]; *(LAS u32x4*)(vst + i_ * 32 * 320) = VR[i_]; } } while (0)
    DF_LOAD(krA, vrA, t_lo);
    if (t_lo + 1 <= t_hi) DF_LOAD(krB, vrB, t_lo + 1);
    if (t_lo + 2 <= t_hi) DF_LOAD(krC, vrC, t_lo + 2);
    for (int tt = t_lo; tt <= t_hi; tt += 3) {
#pragma unroll
      for (int par = 0; par < 3; ++par) {
        const int t = tt + par;
        if (t <= t_hi) {
        __syncthreads();
        if (par == 0) DF_STORE(krA, vrA); else if (par == 1) DF_STORE(krB, vrB); else DF_STORE(krC, vrC);
        __syncthreads();
        if (t + 3 <= t_hi) { if (par == 0) DF_LOAD(krA, vrA, t + 3); else if (par == 1) DF_LOAD(krB, vrB, t + 3); else DF_LOAD(krC, vrC, t + 3); }
        if (t <= qc && t >= qc - 16) {
            f32x16 acc[2];
#pragma unroll
            for (int sub = 0; sub < 2; ++sub)
#pragma unroll
                for (int i = 0; i < 16; ++i) acc[sub][i] = 0.f;
#pragma unroll
            for (int ks = 0; ks < 4; ++ks)
#pragma unroll
                for (int sub = 0; sub < 2; ++sub) { const bf16x8 kf = *(LAS bf16x8*)(kfr + sub * 32 * 272 + 32 * ks); acc[sub] = MFMA32(kf, qf[ks], acc[sub]); }
            const int tb = tb0 + t * 64;
            typedef float f32x2 __attribute__((ext_vector_type(2)));
            f32x2 v2[2][8]; float vm = -1e30f;
            const f32x2 c2 = {0.18033688011112042f, 0.18033688011112042f};
            if (t * 64 + 63 - qw <= -91) {
                const float bc = tab[0]; const f32x2 b2 = {bc, bc};
#pragma unroll
                for (int sub = 0; sub < 2; ++sub)
#pragma unroll
                    for (int j = 0; j < 8; ++j) { const f32x2 a2 = {acc[sub][2 * j], acc[sub][2 * j + 1]}; v2[sub][j] = a2 * c2 + b2; }
            } else {
#pragma unroll
                for (int sub = 0; sub < 2; ++sub)
#pragma unroll
                    for (int j = 0; j < 8; ++j) { const int i = 2 * j; const f32x2 a2 = {acc[sub][i], acc[sub][i + 1]};
                        const f32x2 b2 = {tab[tb + sub * 32 + (i & 3) + 8 * (i >> 2)], tab[tb + sub * 32 + (i & 3) + 1 + 8 * (i >> 2)]}; v2[sub][j] = a2 * c2 + b2; }
            }
#pragma unroll
            for (int sub = 0; sub < 2; ++sub)
#pragma unroll
                for (int j = 0; j < 8; ++j) vm = fmaxf(vm, fmaxf(v2[sub][j].x, v2[sub][j].y));
            vm = fmaxf(vm, xor32(vm));
            if (__any(vm > mrun + 8.f)) {
                const float mn = fmaxf(mrun, vm), alpha = __builtin_amdgcn_exp2f(mrun - mn);
                lsum *= alpha; mrun = mn;
#pragma unroll
                for (int dt = 0; dt < 4; ++dt)
#pragma unroll
                    for (int i = 0; i < 16; ++i) O[dt][i] *= alpha;
            }
            const f32x2 m2 = {mrun, mrun}; f32x2 ls2 = {0.f, 0.f};
#pragma unroll
            for (int sub = 0; sub < 2; ++sub) {
                float w[16];
#pragma unroll
                for (int j = 0; j < 8; ++j) { const f32x2 d2 = v2[sub][j] - m2; f32x2 e2; e2.x = __builtin_amdgcn_exp2f(d2.x); e2.y = __builtin_amdgcn_exp2f(d2.y); ls2 += e2; w[2 * j] = e2.x; w[2 * j + 1] = e2.y; }
#pragma unroll
                for (int s = 0; s < 2; ++s) {
                    u32x4 wp; wp.x = pk2(w[8 * s], w[8 * s + 1]); wp.y = pk2(w[8 * s + 2], w[8 * s + 3]); wp.z = pk2(w[8 * s + 4], w[8 * s + 5]); wp.w = pk2(w[8 * s + 6], w[8 * s + 7]);
                    const bf16x8 wf = __builtin_bit_cast(bf16x8, wp);
#pragma unroll
                    for (int dt = 0; dt < 4; ++dt) {
                        const s16x4 lo = tr_read(vtr + (sub * 32 + 16 * s) * 320 + 64 * dt), hi = tr_read(vtr + (sub * 32 + 16 * s + 8) * 320 + 64 * dt);
                        const bf16x8 vf = __builtin_shufflevector(lo, hi, 0, 1, 2, 3, 4, 5, 6, 7);
                        O[dt] = MFMA32(vf, wf, O[dt]); }
                }
            }
            lsum += ls2.x + ls2.y;
        }
        }
      }
    }
#undef DF_LOAD
#undef DF_STORE
    const float ltot = lsum + xor32(lsum);
    const float cm = (m == 0 ? 1.f : -lam) / ltot;
    if (m == 1) {
#pragma unroll
        for (int dt = 0; dt < 4; ++dt)
#pragma unroll
            for (int i = 0; i < 16; ++i) exch[(dt * 16 + i) * 64 + lane] = O[dt][i] * cm;
    }
    __syncthreads();
    if (m == 0) {
        float ss = 0.f;
#pragma unroll
        for (int dt = 0; dt < 4; ++dt)
#pragma unroll
            for (int i = 0; i < 16; ++i) { O[dt][i] = O[dt][i] * cm + exch[(dt * 16 + i) * 64 + lane]; ss += O[dt][i] * O[dt][i]; }
        ss += xor32(ss);
        const float sc = rsqrtf(ss * (1.f / 128.f) + 1e-6f) * (1.f - lam_init);
        const float* sg = p.diff_subln_g + l * 128 + 4 * hh;
        bf16* yp = Y + (size_t)(b * S + qw + r) * D + 512 + hd * 128 + 4 * hh;
#pragma unroll
        for (int dt = 0; dt < 4; ++dt)
#pragma unroll
            for (int gq = 0; gq < 4; ++gq) { const f32x4 gv = *(const f32x4*)(sg + 32 * dt + 8 * gq); u32x2 o;
                o.x = pk2(O[dt][4 * gq] * sc * gv[0], O[dt][4 * gq + 1] * sc * gv[1]); o.y = pk2(O[dt][4 * gq + 2] * sc * gv[2], O[dt][4 * gq + 3] * sc * gv[3]);
                *(u32x2*)(yp + 32 * dt + 8 * gq) = o; }
    }
}

DI void lru1_unit(const Params& p, int l, const bf16* P, bf16* HL, bf16* YB, float* car, int gc, LAS unsigned char* lds) {
    const int tid = otid(), lane = tid & 63, wave = __builtin_amdgcn_readfirstlane(tid >> 6), r = lane & 31, hh = lane >> 5;
    const int cb = wave * 64, c = cb + lane, t0 = gc * 128, s0 = (gc & 127) * 128;
    LAS float* buf1 = (LAS float*)(lds + wave * 16384); LAS float* buf2 = (LAS float*)(lds + wave * 16384 + 8192); LAS bf16* xcb = (LAS bf16*)buf2;
    bf16x8 wf[2][2][4];
    { const float* wg = p.lru_w_gate + (size_t)l * 2 * 8 * 64 * 64;
#pragma unroll
      for (int g = 0; g < 2; ++g)
#pragma unroll
        for (int nt = 0; nt < 2; ++nt)
#pragma unroll
          for (int ks = 0; ks < 4; ++ks) { const float* wp = wg + ((size_t)((g * 8 + wave) * 64 + 16 * ks + 8 * hh)) * 64 + r + 32 * nt; u32x4 w;
              w.x = pk2(wp[0], wp[64]); w.y = pk2(wp[128], wp[192]); w.z = pk2(wp[256], wp[320]); w.w = pk2(wp[384], wp[448]); wf[g][nt][ks] = __builtin_bit_cast(bf16x8, w); } }
    float cw[4];
#pragma unroll
    for (int k = 0; k < 4; ++k) cw[k] = p.lru_conv_w[(l * 4 + k) * 512 + c];
    const float cbias = p.lru_conv_b[l * 512 + c];
    float br[2], bi[2], spl[2];
#pragma unroll
    for (int nt = 0; nt < 2; ++nt) { const int cc = cb + r + 32 * nt; br[nt] = p.lru_b_gate[(l * 2) * 512 + cc]; bi[nt] = p.lru_b_gate[(l * 2 + 1) * 512 + cc];
        spl[nt] = 8.f * log1pf(expf(-p.lru_lambda[l * 512 + cc])); }
    float hrun = 0.f, arun = 1.f, xm3 = 0.f, xm2 = 0.f, xm1 = 0.f;
    const bf16* xp = P + (size_t)t0 * NIN + C_LX + c;
    if (s0 != 0) { xm3 = bf2f(xp[-3 * NIN]); xm2 = bf2f(xp[-2 * NIN]); xm1 = bf2f(xp[-1 * NIN]); }
    for (int st = 0; st < 4; ++st) {
        float xv[32];
#pragma unroll
        for (int k = 0; k < 32; ++k) xv[k] = bf2f(xp[(size_t)(st * 32 + k) * NIN]);
#pragma unroll
        for (int k = 0; k < 32; ++k) { const float xc = cw[0] * xm3 + cw[1] * xm2 + cw[2] * xm1 + cw[3] * xv[k] + cbias; buf1[k * 64 + lane] = xc; xcb[k * 72 + lane] = f2bf(xc); xm3 = xm2; xm2 = xm1; xm1 = xv[k]; }
        __syncthreads();
        f32x16 G[2][2];
#pragma unroll
        for (int g = 0; g < 2; ++g)
#pragma unroll
            for (int nt = 0; nt < 2; ++nt)
#pragma unroll
                for (int i = 0; i < 16; ++i) G[g][nt][i] = 0.f;
#pragma unroll
        for (int ks = 0; ks < 4; ++ks) { const bf16x8 af = *(LAS bf16x8*)(xcb + r * 72 + 16 * ks + 8 * hh);
#pragma unroll
            for (int g = 0; g < 2; ++g)
#pragma unroll
                for (int nt = 0; nt < 2; ++nt) G[g][nt] = MFMA32(af, wf[g][nt][ks], G[g][nt]); }
        __syncthreads();
#pragma unroll
        for (int nt = 0; nt < 2; ++nt)
#pragma unroll
            for (int i = 0; i < 16; ++i) { const int tok = (i & 3) + 8 * (i >> 2) + 4 * hh, idx = tok * 64 + r + 32 * nt; const float xc = buf1[idx];
                const float rg = sigmoidf_(G[0][nt][i] + br[nt]), ig = sigmoidf_(G[1][nt][i] + bi[nt]); const float la = -rg * spl[nt];
                const float a = __expf(la), bq = __builtin_amdgcn_sqrtf(fmaxf(1.f - a * a, 0.f)) * ig * xc; buf1[idx] = a; buf2[idx] = bq; }
        __syncthreads();
        bf16* hp = HL + (size_t)(t0 + st * 32) * 512 + c; bf16* bp = YB + (size_t)(t0 + st * 32) * 512 + c;
#pragma unroll 8
        for (int k = 0; k < 32; ++k) { const float a = buf1[k * 64 + lane], bq = buf2[k * 64 + lane]; hrun = a * hrun + bq; arun *= a; hp[k * 512] = f2bf(hrun); bp[k * 512] = f2bf(arun); }
        __syncthreads();
    }
    car[(size_t)gc * 1024 + c] = arun; car[(size_t)gc * 1024 + 512 + c] = hrun;
}
DI void lru3_unit(const bf16* P, bf16* Y, const bf16* HL, const bf16* YB, const float* car, int gc, LAS unsigned char* lds) {
    const int tid = otid(), c = tid, j = gc & 127, lane = tid & 63, wave = tid >> 6;
    float H = 0.f;
    const float* cp = car + (size_t)(gc - j) * 1024 + c;
    for (int i0 = 0; i0 < j; i0 += 16) {
        float a[16], h[16];
#pragma unroll
        for (int k = 0; k < 16; ++k) { const int i = (i0 + k < j) ? i0 + k : j - 1; a[k] = cp[(size_t)i * 1024]; h[k] = cp[(size_t)i * 1024 + 512]; }
#pragma unroll
        for (int k = 0; k < 16; ++k) if (i0 + k < j) H = a[k] * H + h[k];
    }
    LAS float* Hs = (LAS float*)lds;
    Hs[c] = H;
    __syncthreads();
    float hv[8];
#pragma unroll
    for (int e = 0; e < 8; ++e) hv[e] = Hs[lane * 8 + e];
    const size_t t0 = (size_t)gc * 128 + wave;
#pragma unroll 1
    for (int kb = 0; kb < 16; kb += 8) {
        u32x4 ya[8], yb[8], yg[8];
#pragma unroll
        for (int k = 0; k < 8; ++k) { const size_t t = t0 + 8 * (kb + k); ya[k] = *(const u32x4*)(HL + t * 512 + lane * 8); yb[k] = *(const u32x4*)(YB + t * 512 + lane * 8); yg[k] = *(const u32x4*)(P + t * NIN + C_LG + lane * 8); }
#pragma unroll
        for (int k = 0; k < 8; ++k) { const size_t t = t0 + 8 * (kb + k); float av[8], bv[8], gv[8]; unpack8(ya[k], av); unpack8(yb[k], bv); unpack8(yg[k], gv);
#pragma unroll
            for (int e = 0; e < 8; ++e) av[e] = (av[e] + bv[e] * hv[e]) * gelu_tanh(gv[e]);
            *(u32x4*)(Y + t * D + 1024 + lane * 8) = pack8(av); }
    }
    __syncthreads();
}
DI void sc_unit(const bf16* P, bf16* Y, const float* w, int unit) {
    const int tid = otid(), lane = tid & 63, wave = tid >> 6, t0 = unit * 32 + wave * 4, s0 = t0 & (S - 1), c0 = lane * 8;
    float pr[6][8];
#pragma unroll
    for (int rr = 0; rr < 6; ++rr) {
        if (s0 - 2 + rr >= 0) { const bf16* rp = P + (size_t)(t0 - 2 + rr) * NIN + c0; float cv[8], xv[8]; unpack8(*(const u32x4*)(rp + C_SCC), cv); unpack8(*(const u32x4*)(rp + C_SCX), xv);
#pragma unroll
            for (int e = 0; e < 8; ++e) pr[rr][e] = cv[e] * xv[e]; }
        else {
#pragma unroll
            for (int e = 0; e < 8; ++e) pr[rr][e] = 0.f; } }
    float w0[8], w1[8], w2[8];
#pragma unroll
    for (int e = 0; e < 8; ++e) { w0[e] = w[c0 + e]; w1[e] = w[512 + c0 + e]; w2[e] = w[1024 + c0 + e]; }
#pragma unroll
    for (int j = 0; j < 4; ++j) { float bv[8], o[8]; unpack8(*(const u32x4*)(P + (size_t)(t0 + j) * NIN + C_SCB + c0), bv);
#pragma unroll
        for (int e = 0; e < 8; ++e) o[e] = bv[e] * (w0[e] * pr[j][e] + w1[e] * pr[j + 1][e] + w2[e] * pr[j + 2][e]);
        *(u32x4*)(Y + (size_t)(t0 + j) * D + 1536 + c0) = pack8(o); }
}
DI void geglu_fix_phase(const bf16* Uh, bf16* Ao, const float* cw) {
    const int tid = otid();
    for (int item = blockIdx.x * NTHREADS + tid; item < 512 * 2 * 512; item += gridDim.x * NTHREADS) {
        const int c0 = (item & 511) * 8, i = (item >> 9) & 1, s = item >> 10;
        const bool first = (s & 255) == 0;
        const int sp = first ? s : s - 1;
        const bf16* r2 = Uh + ((size_t)s * 4 + i) * 8192 + c0;
        const bf16* r1 = i == 0 ? Uh + ((size_t)sp * 4 + 3) * 8192 + c0 : Uh + ((size_t)s * 4 + 0) * 8192 + c0;
        const bf16* r0 = i == 0 ? Uh + ((size_t)sp * 4 + 2) * 8192 + c0 : Uh + ((size_t)sp * 4 + 3) * 8192 + c0;
        float g0[8], g1[8], g2[8], u0[8], u1[8], u2[8], o[8];
        const u32x4 z4 = (u32x4){0u, 0u, 0u, 0u};
        unpack8(*(const u32x4*)r2, g2); unpack8(*(const u32x4*)(r2 + 4096), u2);
        const bool v1 = !(first && i == 0), v0 = !first;
        unpack8(v1 ? *(const u32x4*)r1 : z4, g1); unpack8(v1 ? *(const u32x4*)(r1 + 4096) : z4, u1);
        unpack8(v0 ? *(const u32x4*)r0 : z4, g0); unpack8(v0 ? *(const u32x4*)(r0 + 4096) : z4, u0);
#pragma unroll
        for (int e = 0; e < 8; ++e) { const float gg = cw[c0 + e] * g0[e] + cw[NUP + c0 + e] * g1[e] + cw[2 * NUP + c0 + e] * g2[e];
            const float uu = cw[DFF + c0 + e] * u0[e] + cw[NUP + DFF + c0 + e] * u1[e] + cw[2 * NUP + DFF + c0 + e] * u2[e]; o[e] = gelu_tanh(gg) * uu; }
        *(u32x4*)(Ao + (size_t)(s * 64 + i) * DFF + c0) = pack8(o);
    }
}
#define XB_TMO      128
#define XB_XCNT(j)  (256  + 64 * (j))
#define XB_XSUB(j)  (1280 + 64 * (j))
#define XB_XGEN(j)  (2304 + 64 * (j))
#define XB_TOP      3328
#define XB_TOPGEN   3392
#define XCD_BAR_WORDS 3456
#define XB_SPIN_CAP (1u << 18)

__device__ __forceinline__ unsigned xb_ld(unsigned* p)              { return __hip_atomic_load(p, __ATOMIC_RELAXED, __HIP_MEMORY_SCOPE_AGENT); }
__device__ __forceinline__ unsigned xb_add(unsigned* p, unsigned v) { return __hip_atomic_fetch_add(p, v, __ATOMIC_RELAXED, __HIP_MEMORY_SCOPE_AGENT); }
__device__ __forceinline__ unsigned xb_xcc_id() { return (unsigned)__builtin_amdgcn_s_getreg((3 << 11) | 20) & 0xFu; }
#define XB_SPIN(cond, bar) do { unsigned _sp = 0; while (cond) { __builtin_amdgcn_s_sleep(1); \
    if ((++_sp & 255u) == 0u) { if (xb_ld(&(bar)[XB_TMO])) break; if (_sp > XB_SPIN_CAP) { atomicAdd(&(bar)[XB_TMO], 1u); break; } } } } while (0)

struct XcdBarrier {
    unsigned* bar; unsigned x;
    volatile LAS unsigned* st;
};

__device__ __forceinline__ XcdBarrier xcd_barrier_post(unsigned* bar, volatile LAS unsigned* st) {
    XcdBarrier b; b.bar = bar; b.x = xb_xcc_id(); b.st = st;
    if (threadIdx.x == 0) (void)xb_add(&bar[XB_XCNT(b.x)], 1u);
    return b;
}
__device__ __forceinline__ void xcd_barrier_complete(unsigned* bar, unsigned x, unsigned& nloc, unsigned& nx) {
    const unsigned G = gridDim.x * gridDim.y * gridDim.z;
    unsigned sum, cnt, mine, sp = 0u;
    for (;;) {
        sum = 0u; cnt = 0u; mine = 0u;
#pragma unroll
        for (unsigned j = 0; j < 16; ++j) { const unsigned c = xb_ld(&bar[XB_XCNT(j)]); sum += c; cnt += (c > 0u) ? 1u : 0u; mine = (j == x) ? c : mine; }
        if (sum == G) break;
        __builtin_amdgcn_s_sleep(1);
        if ((++sp & 255u) == 0u) { if (xb_ld(&bar[XB_TMO])) break; if (sp > XB_SPIN_CAP) { atomicAdd(&bar[XB_TMO], 1u); break; } }
    }
    nloc = mine > 0u ? mine : 1u; nx = cnt > 0u ? cnt : 1u;
}

__device__ __forceinline__ void xcd_barrier(const XcdBarrier& b) {
    asm volatile("s_waitcnt vmcnt(0)" ::: "memory");
    __syncthreads();
    if (threadIdx.x == 0) {
        unsigned* bar = b.bar;
        __builtin_amdgcn_s_waitcnt(0);
        unsigned nloc = b.st[0], nx = b.st[1];
        if (nloc == 0u) { xcd_barrier_complete(bar, b.x, nloc, nx); b.st[0] = nloc; b.st[1] = nx; }
        const unsigned old = xb_add(&bar[XB_XSUB(b.x)], 1u);
        const unsigned gen = old / nloc;
        if (old + 1u == (gen + 1u) * nloc) {
            __builtin_amdgcn_fence(__ATOMIC_RELEASE, "agent");
            asm volatile("s_waitcnt vmcnt(0)" ::: "memory");
            const unsigned og = xb_add(&bar[XB_TOP], 1u);
            const unsigned tg = og / nx;
            if (og + 1u == (tg + 1u) * nx) xb_add(&bar[XB_TOPGEN], 1u);
            else XB_SPIN(xb_ld(&bar[XB_TOPGEN]) == tg, bar);
            __builtin_amdgcn_fence(__ATOMIC_ACQUIRE, "agent");
            xb_add(&bar[XB_XGEN(b.x)], 1u);
            asm volatile("s_waitcnt vmcnt(0)" ::: "memory");
        } else {
            XB_SPIN(xb_ld(&bar[XB_XGEN(b.x)]) == gen, bar);
            __builtin_amdgcn_fence(__ATOMIC_ACQUIRE, "agent");
            asm volatile("s_waitcnt vmcnt(0)" ::: "memory");
        }
    }
    __syncthreads();
}


#ifndef GEMM_SP2
#define GEMM_SP2 true
#endif
#ifndef GEMM_ALIGN
#define GEMM_ALIGN true
#endif
__global__ void __launch_bounds__(NTHREADS, 2) fwd_megakernel(Params p) {
    extern __shared__ __attribute__((aligned(16))) unsigned char lds_raw[];
    LAS unsigned char* lds = (LAS unsigned char*)lds_raw;
    cg::grid_group grid = cg::this_grid();
    if (threadIdx.x < 4) ((LAS unsigned*)(lds + LDS_BYTES - 16))[threadIdx.x] = 0u;
    __syncthreads();
    XcdBarrier xbar = xcd_barrier_post((unsigned*)p.ws, (volatile LAS unsigned*)(lds + LDS_BYTES - 16));
    bf16* const wt_in = (bf16*)(p.ws + WS_WIN); bf16* const wt_out = (bf16*)(p.ws + WS_WOUT); bf16* const wt_up = (bf16*)(p.ws + WS_WUP); bf16* const wt_dn = (bf16*)(p.ws + WS_WDN);
    float* const car = (float*)(p.ws + WS_CAR); bf16* const A0 = (bf16*)(p.ws + WS_A0); bf16* const Pb = (bf16*)(p.ws + WS_B); bf16* const Yb = (bf16*)(p.ws + WS_Y);
    bf16* const Ub = (bf16*)(p.ws + WS_B); bf16* const YBb = (bf16*)(p.ws + WS_C); bf16* const HLb = (bf16*)(p.ws + WS_C + 32 * MiB);
    bf16* const Ab = (bf16*)(p.ws + WS_C);
    bf16* const XBa = (bf16*)p.out;
    bf16* const XBb = (bf16*)(p.ws + WS_B + 64 * MiB);
    const int lo = p.ph_lo, hi = p.ph_hi; int ph = 0;
#define PHASE_BEGIN if (ph >= lo && ph < hi) {
#define PHASE_END   if (ph + 1 < hi) { if (hi < 0) grid.sync(); else xcd_barrier(xbar); } } ++ph;
    PHASE_BEGIN
        convert_layer(p, 0, lds);
        norm0_phase(p.x, p.norm_gains, A0);
    PHASE_END
#pragma unroll 1
    for (int l = 0; l < 2; ++l) {
        PHASE_BEGIN
            pg8::Gemm g{A0, wt_in, T, NIN, D}; pg8::StaticOrder So; So.init(T, NIN, (int)gridDim.x, (int)blockIdx.x); pg8::EpiBf16 E{Pb, NIN, 2};
            pg8::gemm_phase<pg8::EpiBf16, pg8::StaticOrder, GEMM_ALIGN, GEMM_SP2>(lds, g, So, E);
        PHASE_END
        PHASE_BEGIN
            for (int u = blockIdx.x; u < 2304; u += gridDim.x) {
                const int xcd = u & 7, loc = (u >> 3) & 31, rnd = (u >> 8) & 3;
                if (u < 1024) { const int sel = loc >> 4, hb = rnd * 2 + sel; df_unit(p, l, Pb, Yb, (xcd * 16 + (loc & 15)) | ((hb & 3) << 7) | ((hb >> 2) << 9), lds); }
                else if (u < 2048) sb_unit(Pb, Yb, (xcd * 32 + loc) | ((rnd & 1) << 8) | ((rnd >> 1) << 9), lds);
                else lru1_unit(p, l, Pb, HLb, YBb, car, u - 2048, lds);
                __syncthreads();
            }
        PHASE_END
        PHASE_BEGIN
            for (int u = blockIdx.x; u < 1280; u += gridDim.x) {
                if (u < 256) lru3_unit(Pb, Yb, HLb, YBb, car, u, lds);
                else sc_unit(Pb, Yb, p.sc_conv_w + l * 3 * 512, u - 256);
            }
        PHASE_END
        PHASE_BEGIN
            pg8::Gemm g{Yb, wt_out, T, D, D}; pg8::StaticOrder So; So.init(T, D, (int)gridDim.x, (int)blockIdx.x); pg8::EpiBf16 E{A0, D, 0};
            pg8::gemm_phase<pg8::EpiBf16, pg8::StaticOrder, GEMM_ALIGN, GEMM_SP2>(lds, g, So, E);
        PHASE_END
        PHASE_BEGIN
            if (l == 0) normres_phase<false, true>(A0, p.x, XBb, p.norm_gains + (l * 4 + 1) * D, p.norm_gains + (l * 4 + 2) * D);
            else normres_phase<true, true>(A0, XBa, XBb, p.norm_gains + (l * 4 + 1) * D, p.norm_gains + (l * 4 + 2) * D);
        PHASE_END
        PHASE_BEGIN
            pg8::Gemm g{A0, wt_up, T, NUP, D}; pg8::StaticOrder So; So.init(T, NUP, (int)gridDim.x, (int)blockIdx.x); pg8::EpiGeglu E{Ab, Ub, p.ffn_conv_w + (size_t)l * 3 * NUP};
            pg8::gemm_phase<pg8::EpiGeglu, pg8::StaticOrder, GEMM_ALIGN, GEMM_SP2>(lds, g, So, E);
        PHASE_END
        PHASE_BEGIN
            geglu_fix_phase(Ub, Ab, p.ffn_conv_w + (size_t)l * 3 * NUP);
        PHASE_END
        PHASE_BEGIN
            pg8::Gemm g{Ab, wt_dn, T, D, DFF}; pg8::StaticOrder So; So.init(T, D, (int)gridDim.x, (int)blockIdx.x); pg8::EpiBf16 E{A0, D, 0};
            pg8::gemm_phase<pg8::EpiBf16, pg8::StaticOrder, GEMM_ALIGN, GEMM_SP2>(lds, g, So, E);
        PHASE_END
        PHASE_BEGIN
            if (l == 0) normres_phase<true, true>(A0, XBb, XBa, p.norm_gains + (l * 4 + 3) * D, p.norm_gains + 4 * D);
            else normres_phase<true, false>(A0, XBb, p.out, p.norm_gains + (l * 4 + 3) * D, nullptr);
            if (l == 0) convert_layer(p, 1, lds);
        PHASE_END
    }
}

extern "C" void kernel_launch(void* const* d_in, const int* in_sizes, int n_in, void* d_out, int out_size, void* d_ws, size_t ws_size, hipStream_t stream) {
    static int grid = 0;
    if (grid == 0) {
        if (n_in != 16 || out_size != T * D || ws_size < WS_END) { fprintf(stderr, "kernel_launch: unexpected shapes (n_in %d out %d ws %zu)\n", n_in, out_size, ws_size); grid = -1; return; }
        int dev = 0, cus = 0, per_cu = 0;
        hipGetDevice(&dev); hipDeviceGetAttribute(&cus, hipDeviceAttributeMultiprocessorCount, dev);
        if (hipFuncSetAttribute((const void*)fwd_megakernel, hipFuncAttributeMaxDynamicSharedMemorySize, LDS_BYTES) != hipSuccess) { fprintf(stderr, "kernel_launch: hipFuncSetAttribute failed\n"); grid = -1; return; }
        if (hipOccupancyMaxActiveBlocksPerMultiprocessor(&per_cu, (const void*)fwd_megakernel, NTHREADS, LDS_BYTES) != hipSuccess || per_cu < 1) { fprintf(stderr, "kernel_launch: occupancy query failed (%d)\n", per_cu); per_cu = 1; }
        (void)hipGetLastError();
        grid = cus * per_cu;
    }
    if (grid < 0) return;
    Params p{};
    p.x = (const float*)d_in[0]; p.norm_gains = (const float*)d_in[1]; p.w_in = (const float*)d_in[2]; p.w_out = (const float*)d_in[3]; p.rel_bias = (const float*)d_in[4];
    p.diff_lambda = (const float*)d_in[5]; p.diff_subln_g = (const float*)d_in[6]; p.lru_conv_w = (const float*)d_in[7]; p.lru_conv_b = (const float*)d_in[8];
    p.lru_w_gate = (const float*)d_in[9]; p.lru_b_gate = (const float*)d_in[10]; p.lru_lambda = (const float*)d_in[11]; p.sc_conv_w = (const float*)d_in[12];
    p.ffn_w_up = (const float*)d_in[13]; p.ffn_conv_w = (const float*)d_in[14]; p.ffn_w_down = (const float*)d_in[15];
    p.out = (float*)d_out; p.ws = (unsigned char*)d_ws; p.ph_lo = 0; p.ph_hi = 1000;
    if (hipMemsetAsync(d_ws, 0, 16384, stream) != hipSuccess) { fprintf(stderr, "kernel_launch: memset of the barrier words failed\n"); return; }
    void* args[] = {&p};
    hipError_t e = hipLaunchCooperativeKernel((const void*)fwd_megakernel, dim3(grid), dim3(NTHREADS), args, LDS_BYTES, stream);
    if (e != hipSuccess) fprintf(stderr, "kernel_launch: cooperative launch failed: %s (grid %d)\n", hipGetErrorString(e), grid);
}
```

```cpp
#include <hip/hip_runtime.h>
#include <hip/hip_cooperative_groups.h>
#include <cstdio>
#include <cstdint>
namespace cg = cooperative_groups;

#ifndef GEMM_PRIO
#define GEMM_PRIO 3
#endif
#include <hip/hip_runtime.h>
namespace pg8 {
#define PG8_LAS __attribute__((address_space(3)))
typedef unsigned short bf16_t;
typedef short bf16x8 __attribute__((ext_vector_type(8)));
typedef float f32x4 __attribute__((ext_vector_type(4)));
typedef unsigned u32x4 __attribute__((ext_vector_type(4)));
constexpr int BM = 256, BK = 64, HALF = 128, HTB = HALF * BK * 2  , STAGE_BYTES = 8 * HTB, NXCD = 8, WGM = 8;

__host__ __device__ __forceinline__ int lds_byte(int r, int c) { const int st = (r >> 4) * 2 + (c >> 5), rr = r & 15, cc = c & 31, ob = rr * 64 + cc * 2; return st * 1024 + (ob ^ (((ob >> 9) & 1) << 5)); }
__host__ __device__ __forceinline__ void stage_rc(int b, int& R, int& C) { const int st = b / 1024, sb = b % 1024, swz = sb ^ (((sb >> 9) & 1) << 5); R = (st >> 1) * 16 + swz / 64; C = (st & 1) * 32 + (swz % 64) / 2; }
__host__ __device__ __forceinline__ int perm32(int rho) { const int n = rho >> 4, i = rho & 15; return 8 * (i >> 2) + 4 * n + (i & 3); }

struct Unit { int pm, pn; };
struct Gemm { const bf16_t* A; const bf16_t* Bt; int M, N, K; };

struct StaticOrder {
    int nM, nN, nwg, G, c;
    __host__ __device__ void init(int M, int N, int G_, int c_) { nM = M / BM; nN = N / BM; nwg = nM * nN; G = G_; c = c_; }
    __host__ __device__ bool next(int i, Unit& u) const {
        const long L = (long)i * G + c; if (L >= nwg) return false;
        int wgid = (int)L; { const int q = nwg / NXCD, r = nwg % NXCD, xcd = wgid % NXCD, off = wgid / NXCD; wgid = (xcd < r ? xcd * (q + 1) : r * (q + 1) + (xcd - r) * q) + off; }
        const int nig = WGM * nN, gid = wgid / nig, fm = gid * WGM, gsz = (nM - fm) < WGM ? (nM - fm) : WGM;
        u.pm = fm + ((wgid % nig) % gsz); u.pn = (wgid % nig) / gsz; return true;
    }
    __device__ __forceinline__ void a_ready(const Unit&) const {}
    __device__ __forceinline__ void done(const Unit&) const {}
};
typedef __bf16 bf16x2v __attribute__((ext_vector_type(2)));
typedef float f32x2 __attribute__((ext_vector_type(2)));
__device__ __forceinline__ unsigned pk2(float a, float b) { f32x2 v = {a, b}; return __builtin_bit_cast(unsigned, __builtin_convertvector(v, bf16x2v)); }
struct EpiBf16 {
    static constexpr bool PERM = true, AFTER_DRAIN = false;
    bf16_t* O; int ldc; int nt;
    __device__ __forceinline__ void operator()(const f32x4 (&acc)[2][2][4][2], const Unit& u, int wr, int wc, int fr, int fq) const {
        const int row0 = u.pm * BM + wr * 64 + fr, col0 = u.pn * BM + wc * 32 + 8 * fq;
        const bool ntu = (nt == 1) || (nt == 2 && !((u.pn >= 2 && u.pn < 6) || (u.pn >= 8 && u.pn < 12)));
#pragma unroll
        for (int ai = 0; ai < 2; ++ai)
#pragma unroll
            for (int m = 0; m < 4; ++m) { bf16_t* rowp = O + (size_t)(row0 + ai * HALF + m * 16) * ldc + col0;
#pragma unroll
                for (int bj = 0; bj < 2; ++bj) { const f32x4 v0 = acc[ai][bj][m][0], v1 = acc[ai][bj][m][1];
                    u32x4 w; w.x = pk2(v0[0], v0[1]); w.y = pk2(v0[2], v0[3]); w.z = pk2(v1[0], v1[1]); w.w = pk2(v1[2], v1[3]);
                    if (ntu) __builtin_nontemporal_store(w, (u32x4*)(rowp + bj * HALF)); else *(u32x4*)(rowp + bj * HALF) = w; } }
    }
};

__device__ __forceinline__ float dpp_f(float oldv, float src, const int ctrl_sel) {
    const int o = __builtin_bit_cast(int, oldv), s = __builtin_bit_cast(int, src); int r;
    if (ctrl_sel == 0) r = __builtin_amdgcn_update_dpp(o, s, 0x121, 0xf, 0xf, true);
    else if (ctrl_sel == 1) r = __builtin_amdgcn_update_dpp(o, s, 0x122, 0xf, 0xf, true);
    else if (ctrl_sel == 2) r = __builtin_amdgcn_update_dpp(o, s, 0x111, 0xf, 0xf, false);
    else r = __builtin_amdgcn_update_dpp(o, s, 0x112, 0xf, 0xf, false);
    return __builtin_bit_cast(float, r);
}
__device__ __forceinline__ float gelu_tanh_e(float x) { const float tt = (x * x) * -1.0294323958e-01f + -2.3022081981e+00f; return x * __builtin_amdgcn_rcpf(1.f + __builtin_amdgcn_exp2f(x * tt)); }
struct EpiGeglu {
    static constexpr bool PERM = true, AFTER_DRAIN = false;
    bf16_t* Ao; bf16_t* Uh; const float* cw;
    __device__ __forceinline__ void operator()(const f32x4 (&acc)[2][2][4][2], const Unit& u, int wr, int wc, int fr, int fq) const {
        const int ch0 = u.pn * 128 + wc * 32 + 8 * fq;
        f32x4 wg[3][2], wu[3][2];
#pragma unroll
        for (int k = 0; k < 3; ++k)
#pragma unroll
            for (int n = 0; n < 2; ++n) { wg[k][n] = *(const f32x4*)(cw + k * 8192 + ch0 + 4 * n); wu[k][n] = *(const f32x4*)(cw + k * 8192 + 4096 + ch0 + 4 * n); }
#pragma unroll
        for (int ai = 0; ai < 2; ++ai) {
            const int strip = u.pm * 4 + ai * 2 + wr;
            f32x4 pg[2], pu[2];
#pragma unroll
            for (int n = 0; n < 2; ++n) { pg[n] = (f32x4){0.f, 0.f, 0.f, 0.f}; pu[n] = (f32x4){0.f, 0.f, 0.f, 0.f}; }
#pragma unroll
            for (int m = 0; m < 4; ++m) {
                f32x4 o[2];
#pragma unroll
                for (int n = 0; n < 2; ++n) { const f32x4 g = acc[ai][0][m][n], up = acc[ai][1][m][n];
#pragma unroll
                    for (int e = 0; e < 4; ++e) {
                        const float g1 = dpp_f(dpp_f(0.f, pg[n][e], 0), g[e], 2), g2 = dpp_f(dpp_f(0.f, pg[n][e], 1), g[e], 3);
                        const float u1 = dpp_f(dpp_f(0.f, pu[n][e], 0), up[e], 2), u2 = dpp_f(dpp_f(0.f, pu[n][e], 1), up[e], 3);
                        const float cg = wg[0][n][e] * g2 + wg[1][n][e] * g1 + wg[2][n][e] * g[e], cu = wu[0][n][e] * u2 + wu[1][n][e] * u1 + wu[2][n][e] * up[e];
                        o[n][e] = gelu_tanh_e(cg) * cu; }
                    pg[n] = g; pu[n] = up; }
                const int row = strip * 64 + 16 * m + fr;
                if (!(m == 0 && fr < 2)) { u32x4 w; w.x = pk2(o[0][0], o[0][1]); w.y = pk2(o[0][2], o[0][3]); w.z = pk2(o[1][0], o[1][1]); w.w = pk2(o[1][2], o[1][3]);
                    *(u32x4*)(Ao + (size_t)row * 4096 + ch0) = w; }
                if ((m == 0 && fr < 2) || (m == 3 && fr >= 14)) { const int slot = (m == 0) ? fr : fr - 12; bf16_t* hp = Uh + ((size_t)strip * 4 + slot) * 8192 + ch0;
                    const f32x4 g0 = acc[ai][0][m][0], g1v = acc[ai][0][m][1], u0 = acc[ai][1][m][0], u1v = acc[ai][1][m][1]; u32x4 w;
                    w.x = pk2(g0[0], g0[1]); w.y = pk2(g0[2], g0[3]); w.z = pk2(g1v[0], g1v[1]); w.w = pk2(g1v[2], g1v[3]); *(u32x4*)hp = w;
                    w.x = pk2(u0[0], u0[1]); w.y = pk2(u0[2], u0[3]); w.z = pk2(u1v[0], u1v[1]); w.w = pk2(u1v[2], u1v[3]); *(u32x4*)(hp + 4096) = w; }
            }
        }
    }
};

template <class Epi, class Sched, bool ALIGN_EPI = false, bool SP2 = false>
__device__ __forceinline__ void gemm_phase(PG8_LAS unsigned char* lds, const Gemm g, const Sched& S, const Epi& E) {
    int tid_ = threadIdx.x; asm volatile("" : "+v"(tid_)); const int tid = tid_, wid = __builtin_amdgcn_readfirstlane(tid >> 6), lane = tid & 63, wr = wid >> 2, wc = wid & 3, fr = lane & 15, fq = lane >> 4;
    const int K = g.K, nt = K / BK;
    unsigned voffA[2], voffB[2];
#pragma unroll
    for (int i = 0; i < 2; ++i) { int R, C; stage_rc(tid * 16 + i * 8192, R, C); const int Rb = Epi::PERM ? ((R & ~31) + perm32(R & 31)) : R;
        voffA[i] = (unsigned)(R * K + C) * 2u; voffB[i] = (unsigned)(Rb * K + C) * 2u; }
    const size_t kstep = (size_t)(BK * 2);
    const size_t hstep = (size_t)HALF * K * 2;
    const size_t tstep = 2 * hstep;
    const unsigned ldsw = (unsigned)wid * 1024u;
    const int aoff = lds_byte(wr * 64 + fr, fq * 8), boff = lds_byte(wc * 32 + fr, fq * 8);
#define PG8_SA(b, h) (((b) * 2 + (h)) * HTB)
#define PG8_SB(b, h) ((4 + (b) * 2 + (h)) * HTB)
#define PG8_STAGE(bufoff, gbase, voff) do { _Pragma("unroll") for (int _i = 0; _i < 2; ++_i) \
        __builtin_amdgcn_global_load_lds((const unsigned*)((const char*)(gbase) + (voff)[_i]), (PG8_LAS unsigned*)(lds + (bufoff) + ldsw + _i * 8192), 16, 0, 0); } while (0)
#define PG8_LDA(dst, b, h) do { _Pragma("unroll") for (int m = 0; m < 4; ++m) _Pragma("unroll") for (int k = 0; k < 2; ++k) dst[m][k] = *(const PG8_LAS bf16x8*)(lds + PG8_SA(b, h) + aoff + m * 2048 + k * 1024); } while (0)
#define PG8_LDB(dst, b, h) do { _Pragma("unroll") for (int n = 0; n < 2; ++n) _Pragma("unroll") for (int k = 0; k < 2; ++k) dst[n][k] = *(const PG8_LAS bf16x8*)(lds + PG8_SB(b, h) + boff + n * 2048 + k * 1024); } while (0)
#define PG8_MMA(ai, bj, At, Bt) do { __builtin_amdgcn_s_setprio(GEMM_PRIO); _Pragma("unroll") for (int m = 0; m < 4; ++m) _Pragma("unroll") for (int n = 0; n < 2; ++n) _Pragma("unroll") for (int k = 0; k < 2; ++k) \
        acc[ai][bj][m][n] = __builtin_amdgcn_mfma_f32_16x16x32_bf16(Bt[n][k], At[m][k], acc[ai][bj][m][n], 0, 0, 0); __builtin_amdgcn_s_setprio(0); } while (0)
#define PG8_WAIT_V(n) asm volatile("s_waitcnt vmcnt(" #n ")" ::: "memory")
#define PG8_WAIT_L(n) asm volatile("s_waitcnt lgkmcnt(" #n ")" ::: "memory")
#define PG8_BAR __builtin_amdgcn_s_barrier()
#define PG8_SCHED __builtin_amdgcn_sched_barrier(0)
    Unit cur, nxt; int ui = 0;
    if (!S.next(0, cur)) return;
    f32x4 acc[2][2][4][2];
#pragma unroll
    for (int a = 0; a < 2; ++a)
#pragma unroll
        for (int b = 0; b < 2; ++b)
#pragma unroll
            for (int m = 0; m < 4; ++m)
#pragma unroll
                for (int n = 0; n < 2; ++n) acc[a][b][m][n] = (f32x4){0.f, 0.f, 0.f, 0.f};
    bf16x8 At[4][2], B0[2][2], B1[2][2];
    const char* cA = (const char*)g.A + (size_t)cur.pm * tstep; const char* cB = (const char*)g.Bt + (size_t)cur.pn * tstep;
    S.a_ready(cur);
    if constexpr (SP2) {
        PG8_STAGE(PG8_SB(0, 0), cB, voffB); PG8_STAGE(PG8_SB(0, 1), cB + hstep, voffB); PG8_STAGE(PG8_SA(0, 0), cA, voffA); PG8_STAGE(PG8_SA(0, 1), cA + hstep, voffA);
        if (wr == 1) PG8_BAR;
        PG8_WAIT_V(2); PG8_BAR;
        PG8_STAGE(PG8_SB(1, 0), cB + kstep, voffB); PG8_STAGE(PG8_SA(1, 0), cA + kstep, voffA); PG8_STAGE(PG8_SB(1, 1), cB + hstep + kstep, voffB);
        PG8_WAIT_V(6); PG8_BAR;
    } else {
        PG8_STAGE(PG8_SB(0, 0), cB, voffB); PG8_STAGE(PG8_SA(0, 0), cA, voffA); PG8_STAGE(PG8_SB(0, 1), cB + hstep, voffB); PG8_STAGE(PG8_SA(0, 1), cA + hstep, voffA);
        if (wr == 1) PG8_BAR;
        PG8_WAIT_V(4); PG8_BAR;
        PG8_STAGE(PG8_SB(1, 0), cB + kstep, voffB); PG8_STAGE(PG8_SA(1, 0), cA + kstep, voffA); PG8_STAGE(PG8_SB(1, 1), cB + hstep + kstep, voffB);
        PG8_WAIT_V(6); PG8_BAR;
    }
    for (;;) {
        const bool has_next = S.next(ui + 1, nxt);
        const char* nA = has_next ? (const char*)g.A + (size_t)nxt.pm * tstep : cA; const char* nB = has_next ? (const char*)g.Bt + (size_t)nxt.pn * tstep : cB;
        for (int t = 0; t < nt; t += 2) {
            const bool last = (t == nt - 2);
            const char* a1 = cA + (size_t)(t + 1) * kstep;
            const char* a2 = last ? nA : cA + (size_t)(t + 2) * kstep; const char* b2 = last ? nB : cB + (size_t)(t + 2) * kstep;
            const char* a3 = a2 + kstep; const char* b3 = b2 + kstep;
            if (last && has_next) S.a_ready(nxt);
            if constexpr (SP2) {
            PG8_LDB(B0, 0, 0); PG8_LDB(B1, 0, 1); PG8_SCHED; PG8_LDA(At, 0, 0); PG8_STAGE(PG8_SA(1, 1), a1 + hstep, voffA);
            PG8_WAIT_V(8); PG8_WAIT_L(0); PG8_BAR; PG8_MMA(0, 0, At, B0); PG8_MMA(0, 1, At, B1); PG8_BAR; PG8_SCHED;
            PG8_LDA(At, 0, 1); PG8_STAGE(PG8_SB(0, 0), b2, voffB); PG8_STAGE(PG8_SB(0, 1), b2 + hstep, voffB); PG8_STAGE(PG8_SA(0, 0), a2, voffA);
            PG8_WAIT_V(8); PG8_WAIT_L(0); PG8_BAR; PG8_MMA(1, 0, At, B0); PG8_MMA(1, 1, At, B1); PG8_BAR; PG8_SCHED;
            PG8_LDB(B0, 1, 0); PG8_LDB(B1, 1, 1); PG8_SCHED; PG8_LDA(At, 1, 0); PG8_STAGE(PG8_SA(0, 1), a2 + hstep, voffA);
            PG8_WAIT_V(8); PG8_WAIT_L(0); PG8_BAR; PG8_MMA(0, 0, At, B0); PG8_MMA(0, 1, At, B1); PG8_BAR; PG8_SCHED;
            PG8_LDA(At, 1, 1); PG8_STAGE(PG8_SB(1, 0), b3, voffB); PG8_STAGE(PG8_SB(1, 1), b3 + hstep, voffB); PG8_STAGE(PG8_SA(1, 0), a3, voffA);
            PG8_WAIT_V(8); PG8_WAIT_L(0); PG8_BAR; PG8_MMA(1, 0, At, B0); PG8_MMA(1, 1, At, B1); PG8_BAR; PG8_SCHED;
            } else {
            PG8_LDB(B0, 0, 0); PG8_SCHED; PG8_LDA(At, 0, 0); PG8_STAGE(PG8_SA(1, 1), a1 + hstep, voffA);
            PG8_WAIT_L(8); PG8_BAR; PG8_WAIT_L(0); PG8_MMA(0, 0, At, B0); PG8_BAR; PG8_SCHED;
            PG8_LDB(B1, 0, 1); PG8_STAGE(PG8_SB(0, 0), b2, voffB);
            PG8_BAR; PG8_WAIT_L(0); PG8_MMA(0, 1, At, B1); PG8_BAR;
            PG8_LDA(At, 0, 1); PG8_STAGE(PG8_SA(0, 0), a2, voffA);
            PG8_BAR; PG8_WAIT_L(0); PG8_MMA(1, 0, At, B0); PG8_BAR; PG8_SCHED;
            PG8_STAGE(PG8_SB(0, 1), b2 + hstep, voffB);
            PG8_WAIT_V(6); PG8_BAR; PG8_MMA(1, 1, At, B1); PG8_BAR;
            PG8_LDB(B0, 1, 0); PG8_SCHED; PG8_LDA(At, 1, 0); PG8_STAGE(PG8_SA(0, 1), a2 + hstep, voffA);
            PG8_WAIT_L(8); PG8_BAR; PG8_WAIT_L(0); PG8_MMA(0, 0, At, B0); PG8_BAR; PG8_SCHED;
            PG8_LDB(B1, 1, 1); PG8_STAGE(PG8_SB(1, 0), b3, voffB);
            PG8_BAR; PG8_WAIT_L(0); PG8_MMA(0, 1, At, B1); PG8_BAR;
            PG8_LDA(At, 1, 1); PG8_STAGE(PG8_SA(1, 0), a3, voffA);
            PG8_BAR; PG8_WAIT_L(0); PG8_MMA(1, 0, At, B0); PG8_BAR; PG8_SCHED;
            PG8_STAGE(PG8_SB(1, 1), b3 + hstep, voffB);
            PG8_WAIT_V(6); PG8_BAR; PG8_MMA(1, 1, At, B1); PG8_BAR;
            }
        }
        if constexpr (ALIGN_EPI) { if (wr == 0) PG8_BAR; }
        if constexpr (!Epi::AFTER_DRAIN) { E(acc, cur, wr, wc, fr, fq); S.done(cur); }
        if (!has_next) break;
#pragma unroll
        for (int a = 0; a < 2; ++a)
#pragma unroll
            for (int b = 0; b < 2; ++b)
#pragma unroll
                for (int m = 0; m < 4; ++m)
#pragma unroll
                    for (int n = 0; n < 2; ++n) acc[a][b][m][n] = (f32x4){0.f, 0.f, 0.f, 0.f};
        cur = nxt; cA = nA; cB = nB; ++ui;
        if constexpr (ALIGN_EPI) { if (wr == 1) PG8_BAR; }
    }
    PG8_WAIT_V(0);
    if constexpr (!ALIGN_EPI) { if (wr == 0) PG8_BAR; }
    PG8_BAR;
    if constexpr (Epi::AFTER_DRAIN) { E.fused(acc, cur, wr, wc, fr, fq, lds, wid, lane); S.done(cur); }
#undef PG8_SA
#undef PG8_SB
#undef PG8_STAGE
#undef PG8_LDA
#undef PG8_LDB
#undef PG8_MMA
#undef PG8_WAIT_V
#undef PG8_WAIT_L
#undef PG8_BAR
#undef PG8_SCHED
}
}
typedef unsigned short bf16;
typedef short bf16x8 __attribute__((ext_vector_type(8)));
typedef short s16x4 __attribute__((ext_vector_type(4)));
typedef float f32x4 __attribute__((ext_vector_type(4)));
typedef float f32x16 __attribute__((ext_vector_type(16)));
typedef unsigned u32x4 __attribute__((ext_vector_type(4)));
typedef unsigned u32x2 __attribute__((ext_vector_type(2)));
#define LAS __attribute__((address_space(3)))
#define DI __device__ __forceinline__
using pg8::pk2;

constexpr int NB = 2, S = 16384, T = NB * S, D = 2048, NIN = 5632, DFF = 4096, NUP = 8192;
constexpr int C_SBQ = 0, C_SBK = 512, C_SBV = 1024, C_DFQ = 1536, C_DFK = 2048, C_DFV = 2560, C_LX = 3072, C_LG = 3584, C_SCB = 4096, C_SCC = 4608, C_SCX = 5120;
constexpr size_t MiB = 1u << 20;
constexpr size_t WS_WIN = 1 * MiB, WS_WOUT = 23 * MiB, WS_WUP = 31 * MiB, WS_WDN = 63 * MiB, WS_CAR = 79 * MiB, WS_A0 = 80 * MiB, WS_B = 208 * MiB, WS_C = 720 * MiB, WS_END = 976 * MiB;
constexpr size_t WS_Y = WS_B + 352 * MiB;
constexpr int LDS_BYTES = 147456;
constexpr int NTHREADS = 512;

struct Params {
    const float* x; const float* norm_gains; const float* w_in; const float* w_out; const float* rel_bias; const float* diff_lambda; const float* diff_subln_g;
    const float* lru_conv_w; const float* lru_conv_b; const float* lru_w_gate; const float* lru_b_gate; const float* lru_lambda; const float* sc_conv_w;
    const float* ffn_w_up; const float* ffn_conv_w; const float* ffn_w_down;
    float* out; unsigned char* ws; int ph_lo, ph_hi;
};

DI int otid() { int t = threadIdx.x; asm volatile("" : "+v"(t)); return t; }
DI float bf2f(unsigned short b) { return __uint_as_float(((unsigned)b) << 16); }
DI unsigned short f2bf(float f) { return (unsigned short)(pk2(f, 0.f) & 0xffffu); }
DI float xor32(float x) { const unsigned u = __builtin_bit_cast(unsigned, x); auto r = __builtin_amdgcn_permlane32_swap(u, u, false, false);
    return __builtin_bit_cast(float, (threadIdx.x & 32) ? (unsigned)r[0] : (unsigned)r[1]); }
DI float wave_sum(float v) {
#pragma unroll
    for (int o = 32; o >= 1; o >>= 1) v += __shfl_xor(v, o);
    return v; }
DI void unpack8(const u32x4 w, float (&v)[8]) {
    v[0] = __uint_as_float(w.x << 16); v[1] = __uint_as_float(w.x & 0xffff0000u); v[2] = __uint_as_float(w.y << 16); v[3] = __uint_as_float(w.y & 0xffff0000u);
    v[4] = __uint_as_float(w.z << 16); v[5] = __uint_as_float(w.z & 0xffff0000u); v[6] = __uint_as_float(w.w << 16); v[7] = __uint_as_float(w.w & 0xffff0000u); }
DI u32x4 pack8(const float (&v)[8]) { u32x4 w; w.x = pk2(v[0], v[1]); w.y = pk2(v[2], v[3]); w.z = pk2(v[4], v[5]); w.w = pk2(v[6], v[7]); return w; }
DI float gelu_tanh(float x) { const float tt = (x * x) * -1.0294323958e-01f + -2.3022081981e+00f; return x * __builtin_amdgcn_rcpf(1.f + __builtin_amdgcn_exp2f(x * tt)); }
DI float sigmoidf_(float x) { return __builtin_amdgcn_rcpf(1.f + __expf(-x)); }
#define MFMA32(a, b, c) __builtin_amdgcn_mfma_f32_32x32x16_bf16((a), (b), (c), 0, 0, 0)
DI s16x4 tr_read(LAS unsigned char* p) { return __builtin_amdgcn_ds_read_tr16_b64_v4i16((LAS s16x4*)p); }

DI void load_row_f32(const float* p, int lane, float (&v)[32]) {
#pragma unroll
    for (int c = 0; c < 4; ++c) { const float* q = p + (c * 64 + lane) * 8; const f32x4 a = *(const f32x4*)q, b = *(const f32x4*)(q + 4);
        v[8 * c] = a[0]; v[8 * c + 1] = a[1]; v[8 * c + 2] = a[2]; v[8 * c + 3] = a[3]; v[8 * c + 4] = b[0]; v[8 * c + 5] = b[1]; v[8 * c + 6] = b[2]; v[8 * c + 7] = b[3]; } }
DI void store_row_f32(float* p, int lane, const float (&v)[32]) {
#pragma unroll
    for (int c = 0; c < 4; ++c) { float* q = p + (c * 64 + lane) * 8; *(f32x4*)q = (f32x4){v[8 * c], v[8 * c + 1], v[8 * c + 2], v[8 * c + 3]}; *(f32x4*)(q + 4) = (f32x4){v[8 * c + 4], v[8 * c + 5], v[8 * c + 6], v[8 * c + 7]}; } }
DI void load_row_bf16(const bf16* p, int lane, float (&v)[32]) {
#pragma unroll
    for (int c = 0; c < 4; ++c) { const u32x4 w = *(const u32x4*)(p + (c * 64 + lane) * 8); float t[8]; unpack8(w, t);
#pragma unroll
        for (int j = 0; j < 8; ++j) v[8 * c + j] = t[j]; } }
DI void store_row_bf16(bf16* p, int lane, const float (&v)[32]) {
#pragma unroll
    for (int c = 0; c < 4; ++c) { u32x4 w; w.x = pk2(v[8 * c], v[8 * c + 1]); w.y = pk2(v[8 * c + 2], v[8 * c + 3]); w.z = pk2(v[8 * c + 4], v[8 * c + 5]); w.w = pk2(v[8 * c + 6], v[8 * c + 7]);
        *(u32x4*)(p + (c * 64 + lane) * 8) = w; } }

struct CvtTile { const float* src; bf16* dst; int K; };
DI bool cvt_select(const Params& p, int l, int i, CvtTile& t, int& N) {
    if (i >= 9984) return false;
    const float* W; bf16* Wt; int K, tile; bool perm = false;
    if (i < 2816) { W = p.w_in + (size_t)l * D * NIN; Wt = (bf16*)(p.ws + WS_WIN); K = D; N = NIN; tile = i; }
    else if (i < 3840) { W = p.w_out + (size_t)l * D * D; Wt = (bf16*)(p.ws + WS_WOUT); K = D; N = D; tile = i - 2816; }
    else if (i < 7936) { W = p.ffn_w_up + (size_t)l * D * NUP; Wt = (bf16*)(p.ws + WS_WUP); K = D; N = NUP; tile = i - 3840; perm = true; }
    else { W = p.ffn_w_down + (size_t)l * DFF * D; Wt = (bf16*)(p.ws + WS_WDN); K = DFF; N = D; tile = i - 7936; }
    const int ntn = N >> 6, tk = tile / ntn, tn = tile - tk * ntn, k0 = tk * 64, n0 = tn * 64;
    const int ns0 = perm ? ((tn >> 1) & 1) * 4096 + (tn >> 2) * 128 + (tn & 1) * 64 : n0;
    t.src = W + (size_t)k0 * N + ns0; t.dst = Wt + (size_t)n0 * K + k0; t.K = K; return true;
}
DI void convert_layer(const Params& p, int l, LAS unsigned char* lds) {
    const int tid = otid();
    LAS bf16* tl = (LAS bf16*)lds;
    const int kp = (tid >> 4) * 2, n4 = (tid & 15) * 4;
    const int n = tid >> 3, k8 = (tid & 7) * 8;
    CvtTile cur, nxt; int N = 0, Nn = 0;
    int i = blockIdx.x;
    bool have = cvt_select(p, l, i, cur, N);
    f32x4 v0 = (f32x4){0.f, 0.f, 0.f, 0.f}, v1 = v0;
    if (have) { v0 = *(const f32x4*)(cur.src + (size_t)kp * N + n4); v1 = *(const f32x4*)(cur.src + (size_t)(kp + 1) * N + n4); }
    while (have) {
#pragma unroll
        for (int j = 0; j < 4; ++j) *(LAS unsigned*)(tl + (n4 + j) * 72 + kp) = pk2(v0[j], v1[j]);
        i += gridDim.x;
        const bool hn = cvt_select(p, l, i, nxt, Nn);
        if (hn) { v0 = *(const f32x4*)(nxt.src + (size_t)kp * Nn + n4); v1 = *(const f32x4*)(nxt.src + (size_t)(kp + 1) * Nn + n4); }
        __syncthreads();
        const u32x4 o = *(LAS u32x4*)(tl + n * 72 + k8);
        *(u32x4*)(cur.dst + (size_t)n * cur.K + k8) = o;
        __syncthreads();
        cur = nxt; N = Nn; have = hn;
    }
}

DI void norm0_phase(const float* x, const float* g, bf16* hb) {
    const int tid = otid(), lane = tid & 63, wave = tid >> 6;
    float gv[32]; load_row_f32(g, lane, gv);
    for (int row = blockIdx.x * 8 + wave; row < T; row += gridDim.x * 8) {
        float v[32]; load_row_f32(x + (size_t)row * D, lane, v);
        float ss = 0.f;
#pragma unroll
        for (int e = 0; e < 32; ++e) ss += v[e] * v[e];
        ss = wave_sum(ss); const float r = rsqrtf(ss * (1.f / 2048.f) + 1e-6f);
#pragma unroll
        for (int e = 0; e < 32; ++e) v[e] = v[e] * r * gv[e];
        store_row_bf16(hb + (size_t)row * D, lane, v);
    }
}
template <bool INBF, bool OUTBF>
DI void normres_phase(bf16* mix, const void* xin_, void* xout_, const float* gA, const float* gB) {
    const int tid = otid(), lane = tid & 63, wave = tid >> 6;
    float ga[32], gb[32];
    load_row_f32(gA, lane, ga);
    if (gB) load_row_f32(gB, lane, gb);
    const int rstep = gridDim.x * 8;
    int row = blockIdx.x * 8 + wave;
    u32x4 rm[4]; f32x4 rx[INBF ? 1 : 8]; u32x4 rxb[INBF ? 4 : 1];
#define NR_LOAD(rw) do { _Pragma("unroll") for (int c = 0; c < 4; ++c) { rm[c] = *(const u32x4*)(mix + (size_t)(rw) * D + (c * 64 + lane) * 8); \
        if constexpr (INBF) rxb[c] = *(const u32x4*)((const bf16*)xin_ + (size_t)(rw) * D + (c * 64 + lane) * 8); \
        else { const float* q = (const float*)xin_ + (size_t)(rw) * D + (c * 64 + lane) * 8; rx[2 * c] = *(const f32x4*)q; rx[2 * c + 1] = *(const f32x4*)(q + 4); } } } while (0)
    NR_LOAD(row);
    for (; row < T; row += rstep) {
        float m[32], xv[32];
#pragma unroll
        for (int c = 0; c < 4; ++c) { float t8[8]; unpack8(rm[c], t8);
#pragma unroll
            for (int j = 0; j < 8; ++j) m[8 * c + j] = t8[j];
            if constexpr (INBF) { unpack8(rxb[c], t8);
#pragma unroll
                for (int j = 0; j < 8; ++j) xv[8 * c + j] = t8[j]; }
            else {
#pragma unroll
                for (int j = 0; j < 4; ++j) { xv[8 * c + j] = rx[2 * c][j]; xv[8 * c + 4 + j] = rx[2 * c + 1][j]; } } }
        const int nrow = row + rstep;
        if (nrow < T) NR_LOAD(nrow);
        float ss = 0.f;
#pragma unroll
        for (int e = 0; e < 32; ++e) ss += m[e] * m[e];
        ss = wave_sum(ss); const float r1 = rsqrtf(ss * (1.f / 2048.f) + 1e-6f);
#pragma unroll
        for (int e = 0; e < 32; ++e) xv[e] += m[e] * r1 * ga[e];
        if constexpr (OUTBF) store_row_bf16((bf16*)xout_ + (size_t)row * D, lane, xv); else store_row_f32((float*)xout_ + (size_t)row * D, lane, xv);
        if (gB) {
            float s2 = 0.f;
#pragma unroll
            for (int e = 0; e < 32; ++e) s2 += xv[e] * xv[e];
            s2 = wave_sum(s2); const float r2 = rsqrtf(s2 * (1.f / 2048.f) + 1e-6f);
#pragma unroll
            for (int e = 0; e < 32; ++e) m[e] = xv[e] * r2 * gb[e];
            store_row_bf16(mix + (size_t)row * D, lane, m);
        }
    }
#undef NR_LOAD
}
template <bool MASK>
DI void sb_sub(LAS unsigned char* kfs, LAS unsigned char* vts, const bf16x8 (&qf)[4], f32x16 (&O)[2], float& Rp, int kb, int q, int hh) {
    f32x16 acc;
#pragma unroll
    for (int i = 0; i < 16; ++i) acc[i] = 0.f;
#pragma unroll
    for (int ks = 0; ks < 4; ++ks) { const bf16x8 kf = *(LAS bf16x8*)(kfs + 32 * ks); acc = MFMA32(kf, qf[ks], acc); }
    float z[16], L[16];
#pragma unroll
    for (int i = 0; i < 16; ++i) { const float t = acc[i] * 0.18033688011112042f; const float e = __builtin_amdgcn_exp2f(fminf(t, 126.f)); const float l2 = fmaxf(__builtin_amdgcn_logf(1.f + e), t);
        if (MASK) { const int key = kb + (i & 3) + 8 * (i >> 2); const bool al = (key < q) && (key >= q - 1024); L[i] = al ? l2 : 0.f; z[i] = al ? t : -1e30f; }
        else { L[i] = l2; z[i] = t; } }
    float Gs[4], Gp[4];
#pragma unroll
    for (int g = 0; g < 4; ++g) { L[4 * g + 2] += L[4 * g + 3]; L[4 * g + 1] += L[4 * g + 2]; L[4 * g] += L[4 * g + 1]; Gs[g] = L[4 * g]; }
#pragma unroll
    for (int g = 0; g < 4; ++g) Gp[g] = xor32(Gs[g]);
    float run = Rp;
#pragma unroll
    for (int g = 3; g >= 0; --g) { const float off = hh ? run : run + Gp[g];
#pragma unroll
        for (int j = 0; j < 4; ++j) L[4 * g + j] += off;
        run += Gs[g] + Gp[g]; }
    Rp = run;
    float w[16];
#pragma unroll
    for (int i = 0; i < 16; ++i) w[i] = __builtin_amdgcn_exp2f(z[i] - L[i]);
#pragma unroll
    for (int s = 0; s < 2; ++s) {
        u32x4 wp; wp.x = pk2(w[8 * s], w[8 * s + 1]); wp.y = pk2(w[8 * s + 2], w[8 * s + 3]); wp.z = pk2(w[8 * s + 4], w[8 * s + 5]); wp.w = pk2(w[8 * s + 6], w[8 * s + 7]);
        const bf16x8 wf = __builtin_bit_cast(bf16x8, wp);
#pragma unroll
        for (int dt = 0; dt < 2; ++dt) {
            const s16x4 lo = tr_read(vts + (16 * s) * 192 + 64 * dt), hi = tr_read(vts + (16 * s + 8) * 192 + 64 * dt);
            const bf16x8 vf = __builtin_shufflevector(lo, hi, 0, 1, 2, 3, 4, 5, 6, 7);
            O[dt] = MFMA32(vf, wf, O[dt]); }
    }
}
DI void sb_unit(const bf16* P, bf16* Y, int unit, LAS unsigned char* lds) {
    const int tid = otid(), lane = tid & 63, wave = __builtin_amdgcn_readfirstlane(tid >> 6), r = lane & 31, hh = lane >> 5;
    const int qb = unit & 255, hg = (unit >> 8) & 1, b = unit >> 9;
    const int hl = wave >> 1, h = hg * 4 + hl, qw = qb * 64 + (wave & 1) * 32;
    const bf16* Pb = P + (size_t)b * S * NIN;
    bf16x8 qf[4];
    { const bf16* qp = Pb + (size_t)(qw + r) * NIN + C_SBQ + h * 64 + 8 * hh;
#pragma unroll
      for (int ks = 0; ks < 4; ++ks) qf[ks] = *(const bf16x8*)(qp + 16 * ks); }
    f32x16 O[2];
#pragma unroll
    for (int i = 0; i < 16; ++i) { O[0][i] = 0.f; O[1][i] = 0.f; }
    float Rp = 0.f;
    LAS unsigned char* Ks = lds + hl * 21504; LAS unsigned char* Vs = Ks + 9216; LAS unsigned* dflag = (LAS unsigned*)(lds + 86016);
    if (tid < 8) dflag[tid] = 0u;
    const int t_hi = qb; int t_lo = qb - 16; if (t_lo < 0) t_lo = 0;
    const int lrow0 = tid >> 5, lch = tid & 31;
    const bf16* kg = Pb + (size_t)lrow0 * NIN + C_SBK + hg * 256 + lch * 8; const bf16* vg = Pb + (size_t)lrow0 * NIN + C_SBV + hg * 256 + lch * 8;
    LAS unsigned char* kst = lds + (lch >> 3) * 21504 + lrow0 * 144 + (lch & 7) * 16; LAS unsigned char* vst = lds + (lch >> 3) * 21504 + 9216 + lrow0 * 192 + (lch & 7) * 16;
    u32x4 krA[4], vrA[4], krB[4], vrB[4];
#define SB_LOAD(KR, VR, tt) do { _Pragma("unroll") for (int i_ = 0; i_ < 4; ++i_) { KR[i_] = *(const u32x4*)(kg + (size_t)((tt) * 64 + 16 * i_) * NIN); VR[i_] = *(const u32x4*)(vg + (size_t)((tt) * 64 + 16 * i_) * NIN); } } while (0)
#define SB_STORE(KR, VR) do { _Pragma("unroll") for (int i_ = 0; i_ < 4; ++i_) { *(LAS u32x4*)(kst + i_ * 16 * 144) = KR[i_]; *(LAS u32x4*)(vst + i_ * 16 * 192) = VR[i_]; } } while (0)
    SB_LOAD(krA, vrA, t_hi);
    if (t_hi - 1 >= t_lo) SB_LOAD(krB, vrB, t_hi - 1);
    const int q4 = (lane & 15) >> 2, pp = lane & 3, blk = (lane >> 4) & 1;
    LAS unsigned char* vtr = Vs + (4 * hh + q4) * 192 + 32 * blk + 8 * pp;
    LAS unsigned char* kfr = Ks + r * 144 + 16 * hh;
    bool alldone = false;
    for (int tt = t_hi; tt >= t_lo && !alldone; tt -= 2) {
#pragma unroll
      for (int par = 0; par < 2; ++par) {
        const int t = tt - par;
        if (t < t_lo) break;
        __syncthreads();
        { const u32x4 f0 = *(LAS u32x4*)dflag, f1 = *(LAS u32x4*)(dflag + 4);
          if ((f0.x & f0.y & f0.z & f0.w & f1.x & f1.y & f1.z & f1.w) != 0u) { alldone = true; break; } }
        if (par == 0) SB_STORE(krA, vrA); else SB_STORE(krB, vrB);
        __syncthreads();
        if (t - 2 >= t_lo) { if (par == 0) SB_LOAD(krA, vrA, t - 2); else SB_LOAD(krB, vrB, t - 2); }
        const int k0 = t * 64;
#pragma unroll
        for (int sub = 1; sub >= 0; --sub) {
            const int ks0 = k0 + sub * 32;
            if (ks0 < qw + 31 && ks0 + 31 >= qw - 1024) {
                if (ks0 + 31 < qw && ks0 >= qw + 31 - 1024) sb_sub<false>(kfr + sub * 32 * 144, vtr + sub * 32 * 192, qf, O, Rp, ks0 + 4 * hh, qw + r, hh);
                else sb_sub<true>(kfr + sub * 32 * 144, vtr + sub * 32 * 192, qf, O, Rp, ks0 + 4 * hh, qw + r, hh);
            }
        }
        const bool fin = (__all(Rp > 160.f) != 0) || (k0 - 1 < qw - 1024);
        if (fin && lane == 0) dflag[wave] = 1u;
      }
    }
#undef SB_LOAD
#undef SB_STORE
    bf16* yp = Y + (size_t)(b * S + qw + r) * D + h * 64 + 4 * hh;
#pragma unroll
    for (int dt = 0; dt < 2; ++dt)
#pragma unroll
        for (int g = 0; g < 4; ++g) { u32x2 o; o.x = pk2(O[dt][4 * g], O[dt][4 * g + 1]); o.y = pk2(O[dt][4 * g + 2], O[dt][4 * g + 3]); *(u32x2*)(yp + 32 * dt + 8 * g) = o; }
}

DI void df_unit(const Params& p, int l, const bf16* P, bf16* Y, int unit, LAS unsigned char* lds) {
    const int tid = otid(), lane = tid & 63, wave = __builtin_amdgcn_readfirstlane(tid >> 6), r = lane & 31, hh = lane >> 5;
    const int g = wave >> 1, m = wave & 1;
    const int qb = unit & 127, hd = (unit >> 7) & 3, b = unit >> 9;
    const int q0 = qb * 128, qw = q0 + g * 32, qc = qw >> 6;
    const bf16* Pb = P + (size_t)b * S * NIN;
    LAS unsigned char* Ks = lds; LAS unsigned char* Vs = lds + 17408; LAS float* tab = (LAS float*)(lds + 37888); LAS float* exch = (LAS float*)(lds + 43008) + g * 4096;
    const float* lv = p.diff_lambda + l * 256;
    const float s01 = wave_sum(lv[lane] * lv[64 + lane]), s23 = wave_sum(lv[128 + lane] * lv[192 + lane]);
    const float lam_init = 0.8f - 0.6f * expf(-0.3f * (float)l);
    const float lam = expf(s01) - expf(s23) + lam_init;
    for (int idx = tid; idx < 1152; idx += NTHREADS) { const int rel = idx - 1087, n = rel < 0 ? -rel : rel;
        int bk = n < 8 ? n : (n < 12 ? 8 : (n < 16 ? 9 : (n < 23 ? 10 : (n < 32 ? 11 : (n < 46 ? 12 : (n < 64 ? 13 : (n < 91 ? 14 : 15)))))));
        if (rel > 0) bk += 16;
        tab[idx] = p.rel_bias[bk * 4 + hd] * 1.4426950408889634f; }
    bf16x8 qf[4];
    { const bf16* qp = Pb + (size_t)(qw + r) * NIN + C_DFQ + hd * 128 + m * 64 + 8 * hh;
#pragma unroll
      for (int ks = 0; ks < 4; ++ks) qf[ks] = *(const bf16x8*)(qp + 16 * ks); }
    const int t_hi = (q0 >> 6) + 1; int t_lo = (q0 >> 6) - 16; if (t_lo < 0) t_lo = 0;
    const int lrow0 = tid >> 4, lch = tid & 15;
    const bf16* kg = Pb + (size_t)lrow0 * NIN + C_DFK + hd * 128 + lch * 8; const bf16* vg = Pb + (size_t)lrow0 * NIN + C_DFV + hd * 128 + lch * 8;
    LAS unsigned char* kst = Ks + lrow0 * 272 + lch * 16; LAS unsigned char* vst = Vs + lrow0 * 320 + lch * 16;
    LAS unsigned char* kfr = Ks + r * 272 + 16 * hh + m * 128;
    const int q4 = (lane & 15) >> 2, pp = lane & 3, blk = (lane >> 4) & 1;
    LAS unsigned char* vtr = Vs + (4 * hh + q4) * 320 + 32 * blk + 8 * pp;
    const int tb0 = 4 * hh - (qw + r) + 1087;
    float mrun = -1e30f, lsum = 0.f;
    f32x16 O[4];
#pragma unroll
    for (int dt = 0; dt < 4; ++dt)
#pragma unroll
        for (int i = 0; i < 16; ++i) O[dt][i] = 0.f;
    u32x4 krA[2], vrA[2], krB[2], vrB[2], krC[2], vrC[2];
#define DF_LOAD(KR, VR, tt) do { _Pragma("unroll") for (int i_ = 0; i_ < 2; ++i_) { KR[i_] = *(const u32x4*)(kg + (size_t)((tt) * 64 + 32 * i_) * NIN); VR[i_] = *(const u32x4*)(vg + (size_t)((tt) * 64 + 32 * i_) * NIN); } } while (0)
#define DF_STORE(KR, VR) do { _Pragma("unroll") for (int i_ = 0; i_ < 2; ++i_) { *(LAS u32x4*)(kst + i_ * 32 * 272) = KR[i_]; *(LAS u32x4*)(vst + i_ * 32 * 320) = VR[i_]; } } while (0)
    DF_LOAD(krA, vrA, t_lo);
    if (t_lo + 1 <= t_hi) DF_LOAD(krB, vrB, t_lo + 1);
    if (t_lo + 2 <= t_hi) DF_LOAD(krC, vrC, t_lo + 2);
    for (int tt = t_lo; tt <= t_hi; tt += 3) {
#pragma unroll
      for (int par = 0; par < 3; ++par) {
        const int t = tt + par;
        if (t <= t_hi) {
        __syncthreads();
        if (par == 0) DF_STORE(krA, vrA); else if (par == 1) DF_STORE(krB, vrB); else DF_STORE(krC, vrC);
        __syncthreads();
        if (t + 3 <= t_hi) { if (par == 0) DF_LOAD(krA, vrA, t + 3); else if (par == 1) DF_LOAD(krB, vrB, t + 3); else DF_LOAD(krC, vrC, t + 3); }
        if (t <= qc && t >= qc - 16) {
            f32x16 acc[2];
#pragma unroll
            for (int sub = 0; sub < 2; ++sub)
#pragma unroll
                for (int i = 0; i < 16; ++i) acc[sub][i] = 0.f;
#pragma unroll
            for (int ks = 0; ks < 4; ++ks)
#pragma unroll
                for (int sub = 0; sub < 2; ++sub) { const bf16x8 kf = *(LAS bf16x8*)(kfr + sub * 32 * 272 + 32 * ks); acc[sub] = MFMA32(kf, qf[ks], acc[sub]); }
            const int tb = tb0 + t * 64;
            typedef float f32x2 __attribute__((ext_vector_type(2)));
            f32x2 v2[2][8]; float vm = -1e30f;
            const f32x2 c2 = {0.18033688011112042f, 0.18033688011112042f};
            if (t * 64 + 63 - qw <= -91) {
                const float bc = tab[0]; const f32x2 b2 = {bc, bc};
#pragma unroll
                for (int sub = 0; sub < 2; ++sub)
#pragma unroll
                    for (int j = 0; j < 8; ++j) { const f32x2 a2 = {acc[sub][2 * j], acc[sub][2 * j + 1]}; v2[sub][j] = a2 * c2 + b2; }
            } else {
#pragma unroll
                for (int sub = 0; sub < 2; ++sub)
#pragma unroll
                    for (int j = 0; j < 8; ++j) { const int i = 2 * j; const f32x2 a2 = {acc[sub][i], acc[sub][i + 1]};
                        const f32x2 b2 = {tab[tb + sub * 32 + (i & 3) + 8 * (i >> 2)], tab[tb + sub * 32 + (i & 3) + 1 + 8 * (i >> 2)]}; v2[sub][j] = a2 * c2 + b2; }
            }
#pragma unroll
            for (int sub = 0; sub < 2; ++sub)
#pragma unroll
                for (int j = 0; j < 8; ++j) vm = fmaxf(vm, fmaxf(v2[sub][j].x, v2[sub][j].y));
            vm = fmaxf(vm, xor32(vm));
            if (__any(vm > mrun + 8.f)) {
                const float mn = fmaxf(mrun, vm), alpha = __builtin_amdgcn_exp2f(mrun - mn);
                lsum *= alpha; mrun = mn;
#pragma unroll
                for (int dt = 0; dt < 4; ++dt)
#pragma unroll
                    for (int i = 0; i < 16; ++i) O[dt][i] *= alpha;
            }
            const f32x2 m2 = {mrun, mrun}; f32x2 ls2 = {0.f, 0.f};
#pragma unroll
            for (int sub = 0; sub < 2; ++sub) {
                float w[16];
#pragma unroll
                for (int j = 0; j < 8; ++j) { const f32x2 d2 = v2[sub][j] - m2; f32x2 e2; e2.x = __builtin_amdgcn_exp2f(d2.x); e2.y = __builtin_amdgcn_exp2f(d2.y); ls2 += e2; w[2 * j] = e2.x; w[2 * j + 1] = e2.y; }
#pragma unroll
                for (int s = 0; s < 2; ++s) {
                    u32x4 wp; wp.x = pk2(w[8 * s], w[8 * s + 1]); wp.y = pk2(w[8 * s + 2], w[8 * s + 3]); wp.z = pk2(w[8 * s + 4], w[8 * s + 5]); wp.w = pk2(w[8 * s + 6], w[8 * s + 7]);
                    const bf16x8 wf = __builtin_bit_cast(bf16x8, wp);
#pragma unroll
                    for (int dt = 0; dt < 4; ++dt) {
                        const s16x4 lo = tr_read(vtr + (sub * 32 + 16 * s) * 320 + 64 * dt), hi = tr_read(vtr + (sub * 32 + 16 * s + 8) * 320 + 64 * dt);
                        const bf16x8 vf = __builtin_shufflevector(lo, hi, 0, 1, 2, 3, 4, 5, 6, 7);
                        O[dt] = MFMA32(vf, wf, O[dt]); }
                }
            }
            lsum += ls2.x + ls2.y;
        }
        }
      }
    }
#undef DF_LOAD
#undef DF_STORE
    const float ltot = lsum + xor32(lsum);
    const float cm = (m == 0 ? 1.f : -lam) / ltot;
    if (m == 1) {
#pragma unroll
        for (int dt = 0; dt < 4; ++dt)
#pragma unroll
            for (int i = 0; i < 16; ++i) exch[(dt * 16 + i) * 64 + lane] = O[dt][i] * cm;
    }
    __syncthreads();
    if (m == 0) {
        float ss = 0.f;
#pragma unroll
        for (int dt = 0; dt < 4; ++dt)
#pragma unroll
            for (int i = 0; i < 16; ++i) { O[dt][i] = O[dt][i] * cm + exch[(dt * 16 + i) * 64 + lane]; ss += O[dt][i] * O[dt][i]; }
        ss += xor32(ss);
        const float sc = rsqrtf(ss * (1.f / 128.f) + 1e-6f) * (1.f - lam_init);
        const float* sg = p.diff_subln_g + l * 128 + 4 * hh;
        bf16* yp = Y + (size_t)(b * S + qw + r) * D + 512 + hd * 128 + 4 * hh;
#pragma unroll
        for (int dt = 0; dt < 4; ++dt)
#pragma unroll
            for (int gq = 0; gq < 4; ++gq) { const f32x4 gv = *(const f32x4*)(sg + 32 * dt + 8 * gq); u32x2 o;
                o.x = pk2(O[dt][4 * gq] * sc * gv[0], O[dt][4 * gq + 1] * sc * gv[1]); o.y = pk2(O[dt][4 * gq + 2] * sc * gv[2], O[dt][4 * gq + 3] * sc * gv[3]);
                *(u32x2*)(yp + 32 * dt + 8 * gq) = o; }
    }
}

DI void lru1_unit(const Params& p, int l, const bf16* P, bf16* HL, bf16* YB, float* car, int gc, LAS unsigned char* lds) {
    const int tid = otid(), lane = tid & 63, wave = __builtin_amdgcn_readfirstlane(tid >> 6), r = lane & 31, hh = lane >> 5;
    const int cb = wave * 64, c = cb + lane, t0 = gc * 128, s0 = (gc & 127) * 128;
    LAS float* buf1 = (LAS float*)(lds + wave * 16384); LAS float* buf2 = (LAS float*)(lds + wave * 16384 + 8192); LAS bf16* xcb = (LAS bf16*)buf2;
    bf16x8 wf[2][2][4];
    { const float* wg = p.lru_w_gate + (size_t)l * 2 * 8 * 64 * 64;
#pragma unroll
      for (int g = 0; g < 2; ++g)
#pragma unroll
        for (int nt = 0; nt < 2; ++nt)
#pragma unroll
          for (int ks = 0; ks < 4; ++ks) { const float* wp = wg + ((size_t)((g * 8 + wave) * 64 + 16 * ks + 8 * hh)) * 64 + r + 32 * nt; u32x4 w;
              w.x = pk2(wp[0], wp[64]); w.y = pk2(wp[128], wp[192]); w.z = pk2(wp[256], wp[320]); w.w = pk2(wp[384], wp[448]); wf[g][nt][ks] = __builtin_bit_cast(bf16x8, w); } }
    float cw[4];
#pragma unroll
    for (int k = 0; k < 4; ++k) cw[k] = p.lru_conv_w[(l * 4 + k) * 512 + c];
    const float cbias = p.lru_conv_b[l * 512 + c];
    float br[2], bi[2], spl[2];
#pragma unroll
    for (int nt = 0; nt < 2; ++nt) { const int cc = cb + r + 32 * nt; br[nt] = p.lru_b_gate[(l * 2) * 512 + cc]; bi[nt] = p.lru_b_gate[(l * 2 + 1) * 512 + cc];
        spl[nt] = 8.f * log1pf(expf(-p.lru_lambda[l * 512 + cc])); }
    float hrun = 0.f, arun = 1.f, xm3 = 0.f, xm2 = 0.f, xm1 = 0.f;
    const bf16* xp = P + (size_t)t0 * NIN + C_LX + c;
    if (s0 != 0) { xm3 = bf2f(xp[-3 * NIN]); xm2 = bf2f(xp[-2 * NIN]); xm1 = bf2f(xp[-1 * NIN]); }
    for (int st = 0; st < 4; ++st) {
        float xv[32];
#pragma unroll
        for (int k = 0; k < 32; ++k) xv[k] = bf2f(xp[(size_t)(st * 32 + k) * NIN]);
#pragma unroll
        for (int k = 0; k < 32; ++k) { const float xc = cw[0] * xm3 + cw[1] * xm2 + cw[2] * xm1 + cw[3] * xv[k] + cbias; buf1[k * 64 + lane] = xc; xcb[k * 72 + lane] = f2bf(xc); xm3 = xm2; xm2 = xm1; xm1 = xv[k]; }
        __syncthreads();
        f32x16 G[2][2];
#pragma unroll
        for (int g = 0; g < 2; ++g)
#pragma unroll
            for (int nt = 0; nt < 2; ++nt)
#pragma unroll
                for (int i = 0; i < 16; ++i) G[g][nt][i] = 0.f;
#pragma unroll
        for (int ks = 0; ks < 4; ++ks) { const bf16x8 af = *(LAS bf16x8*)(xcb + r * 72 + 16 * ks + 8 * hh);
#pragma unroll
            for (int g = 0; g < 2; ++g)
#pragma unroll
                for (int nt = 0; nt < 2; ++nt) G[g][nt] = MFMA32(af, wf[g][nt][ks], G[g][nt]); }
        __syncthreads();
#pragma unroll
        for (int nt = 0; nt < 2; ++nt)
#pragma unroll
            for (int i = 0; i < 16; ++i) { const int tok = (i & 3) + 8 * (i >> 2) + 4 * hh, idx = tok * 64 + r + 32 * nt; const float xc = buf1[idx];
                const float rg = sigmoidf_(G[0][nt][i] + br[nt]), ig = sigmoidf_(G[1][nt][i] + bi[nt]); const float la = -rg * spl[nt];
                const float a = __expf(la), bq = __builtin_amdgcn_sqrtf(fmaxf(1.f - a * a, 0.f)) * ig * xc; buf1[idx] = a; buf2[idx] = bq; }
        __syncthreads();
        bf16* hp = HL + (size_t)(t0 + st * 32) * 512 + c; bf16* bp = YB + (size_t)(t0 + st * 32) * 512 + c;
#pragma unroll 8
        for (int k = 0; k < 32; ++k) { const float a = buf1[k * 64 + lane], bq = buf2[k * 64 + lane]; hrun = a * hrun + bq; arun *= a; hp[k * 512] = f2bf(hrun); bp[k * 512] = f2bf(arun); }
        __syncthreads();
    }
    car[(size_t)gc * 1024 + c] = arun; car[(size_t)gc * 1024 + 512 + c] = hrun;
}
DI void lru3_unit(const bf16* P, bf16* Y, const bf16* HL, const bf16* YB, const float* car, int gc, LAS unsigned char* lds) {
    const int tid = otid(), c = tid, j = gc & 127, lane = tid & 63, wave = tid >> 6;
    float H = 0.f;
    const float* cp = car + (size_t)(gc - j) * 1024 + c;
    for (int i0 = 0; i0 < j; i0 += 16) {
        float a[16], h[16];
#pragma unroll
        for (int k = 0; k < 16; ++k) { const int i = (i0 + k < j) ? i0 + k : j - 1; a[k] = cp[(size_t)i * 1024]; h[k] = cp[(size_t)i * 1024 + 512]; }
#pragma unroll
        for (int k = 0; k < 16; ++k) if (i0 + k < j) H = a[k] * H + h[k];
    }
    LAS float* Hs = (LAS float*)lds;
    Hs[c] = H;
    __syncthreads();
    float hv[8];
#pragma unroll
    for (int e = 0; e < 8; ++e) hv[e] = Hs[lane * 8 + e];
    const size_t t0 = (size_t)gc * 128 + wave;
#pragma unroll 1
    for (int kb = 0; kb < 16; kb += 8) {
        u32x4 ya[8], yb[8], yg[8];
#pragma unroll
        for (int k = 0; k < 8; ++k) { const size_t t = t0 + 8 * (kb + k); ya[k] = *(const u32x4*)(HL + t * 512 + lane * 8); yb[k] = *(const u32x4*)(YB + t * 512 + lane * 8); yg[k] = *(const u32x4*)(P + t * NIN + C_LG + lane * 8); }
#pragma unroll
        for (int k = 0; k < 8; ++k) { const size_t t = t0 + 8 * (kb + k); float av[8], bv[8], gv[8]; unpack8(ya[k], av); unpack8(yb[k], bv); unpack8(yg[k], gv);
#pragma unroll
            for (int e = 0; e < 8; ++e) av[e] = (av[e] + bv[e] * hv[e]) * gelu_tanh(gv[e]);
            *(u32x4*)(Y + t * D + 1024 + lane * 8) = pack8(av); }
    }
    __syncthreads();
}
DI void sc_unit(const bf16* P, bf16* Y, const float* w, int unit) {
    const int tid = otid(), lane = tid & 63, wave = tid >> 6, t0 = unit * 32 + wave * 4, s0 = t0 & (S - 1), c0 = lane * 8;
    float pr[6][8];
#pragma unroll
    for (int rr = 0; rr < 6; ++rr) {
        if (s0 - 2 + rr >= 0) { const bf16* rp = P + (size_t)(t0 - 2 + rr) * NIN + c0; float cv[8], xv[8]; unpack8(*(const u32x4*)(rp + C_SCC), cv); unpack8(*(const u32x4*)(rp + C_SCX), xv);
#pragma unroll
            for (int e = 0; e < 8; ++e) pr[rr][e] = cv[e] * xv[e]; }
        else {
#pragma unroll
            for (int e = 0; e < 8; ++e) pr[rr][e] = 0.f; } }
    float w0[8], w1[8], w2[8];
#pragma unroll
    for (int e = 0; e < 8; ++e) { w0[e] = w[c0 + e]; w1[e] = w[512 + c0 + e]; w2[e] = w[1024 + c0 + e]; }
#pragma unroll
    for (int j = 0; j < 4; ++j) { float bv[8], o[8]; unpack8(*(const u32x4*)(P + (size_t)(t0 + j) * NIN + C_SCB + c0), bv);
#pragma unroll
        for (int e = 0; e < 8; ++e) o[e] = bv[e] * (w0[e] * pr[j][e] + w1[e] * pr[j + 1][e] + w2[e] * pr[j + 2][e]);
        *(u32x4*)(Y + (size_t)(t0 + j) * D + 1536 + c0) = pack8(o); }
}
DI void geglu_fix_phase(const bf16* Uh, bf16* Ao, const float* cw) {
    const int tid = otid();
    for (int item = blockIdx.x * NTHREADS + tid; item < 512 * 2 * 512; item += gridDim.x * NTHREADS) {
        const int c0 = (item & 511) * 8, i = (item >> 9) & 1, s = item >> 10;
        const bool first = (s & 255) == 0;
        const int sp = first ? s : s - 1;
        const bf16* r2 = Uh + ((size_t)s * 4 + i) * 8192 + c0;
        const bf16* r1 = i == 0 ? Uh + ((size_t)sp * 4 + 3) * 8192 + c0 : Uh + ((size_t)s * 4 + 0) * 8192 + c0;
        const bf16* r0 = i == 0 ? Uh + ((size_t)sp * 4 + 2) * 8192 + c0 : Uh + ((size_t)sp * 4 + 3) * 8192 + c0;
        float g0[8], g1[8], g2[8], u0[8], u1[8], u2[8], o[8];
        const u32x4 z4 = (u32x4){0u, 0u, 0u, 0u};
        unpack8(*(const u32x4*)r2, g2); unpack8(*(const u32x4*)(r2 + 4096), u2);
        const bool v1 = !(first && i == 0), v0 = !first;
        unpack8(v1 ? *(const u32x4*)r1 : z4, g1); unpack8(v1 ? *(const u32x4*)(r1 + 4096) : z4, u1);
        unpack8(v0 ? *(const u32x4*)r0 : z4, g0); unpack8(v0 ? *(const u32x4*)(r0 + 4096) : z4, u0);
#pragma unroll
        for (int e = 0; e < 8; ++e) { const float gg = cw[c0 + e] * g0[e] + cw[NUP + c0 + e] * g1[e] + cw[2 * NUP + c0 + e] * g2[e];
            const float uu = cw[DFF + c0 + e] * u0[e] + cw[NUP + DFF + c0 + e] * u1[e] + cw[2 * NUP + DFF + c0 + e] * u2[e]; o[e] = gelu_tanh(gg) * uu; }
        *(u32x4*)(Ao + (size_t)(s * 64 + i) * DFF + c0) = pack8(o);
    }
}
#define XB_TMO      128
#define XB_XCNT(j)  (256  + 64 * (j))
#define XB_XSUB(j)  (1280 + 64 * (j))
#define XB_XGEN(j)  (2304 + 64 * (j))
#define XB_TOP      3328
#define XB_TOPGEN   3392
#define XCD_BAR_WORDS 3456
#define XB_SPIN_CAP (1u << 18)

__device__ __forceinline__ unsigned xb_ld(unsigned* p)              { return __hip_atomic_load(p, __ATOMIC_RELAXED, __HIP_MEMORY_SCOPE_AGENT); }
__device__ __forceinline__ unsigned xb_add(unsigned* p, unsigned v) { return __hip_atomic_fetch_add(p, v, __ATOMIC_RELAXED, __HIP_MEMORY_SCOPE_AGENT); }
__device__ __forceinline__ unsigned xb_xcc_id() { return (unsigned)__builtin_amdgcn_s_getreg((3 << 11) | 20) & 0xFu; }
#define XB_SPIN(cond, bar) do { unsigned _sp = 0; while (cond) { __builtin_amdgcn_s_sleep(1); \
    if ((++_sp & 255u) == 0u) { if (xb_ld(&(bar)[XB_TMO])) break; if (_sp > XB_SPIN_CAP) { atomicAdd(&(bar)[XB_TMO], 1u); break; } } } } while (0)

struct XcdBarrier {
    unsigned* bar; unsigned x;
    volatile LAS unsigned* st;
};

__device__ __forceinline__ XcdBarrier xcd_barrier_post(unsigned* bar, volatile LAS unsigned* st) {
    XcdBarrier b; b.bar = bar; b.x = xb_xcc_id(); b.st = st;
    if (threadIdx.x == 0) (void)xb_add(&bar[XB_XCNT(b.x)], 1u);
    return b;
}
__device__ __forceinline__ void xcd_barrier_complete(unsigned* bar, unsigned x, unsigned& nloc, unsigned& nx) {
    const unsigned G = gridDim.x * gridDim.y * gridDim.z;
    unsigned sum, cnt, mine, sp = 0u;
    for (;;) {
        sum = 0u; cnt = 0u; mine = 0u;
#pragma unroll
        for (unsigned j = 0; j < 16; ++j) { const unsigned c = xb_ld(&bar[XB_XCNT(j)]); sum += c; cnt += (c > 0u) ? 1u : 0u; mine = (j == x) ? c : mine; }
        if (sum == G) break;
        __builtin_amdgcn_s_sleep(1);
        if ((++sp & 255u) == 0u) { if (xb_ld(&bar[XB_TMO])) break; if (sp > XB_SPIN_CAP) { atomicAdd(&bar[XB_TMO], 1u); break; } }
    }
    nloc = mine > 0u ? mine : 1u; nx = cnt > 0u ? cnt : 1u;
}

__device__ __forceinline__ void xcd_barrier(const XcdBarrier& b) {
    asm volatile("s_waitcnt vmcnt(0)" ::: "memory");
    __syncthreads();
    if (threadIdx.x == 0) {
        unsigned* bar = b.bar;
        __builtin_amdgcn_s_waitcnt(0);
        unsigned nloc = b.st[0], nx = b.st[1];
        if (nloc == 0u) { xcd_barrier_complete(bar, b.x, nloc, nx); b.st[0] = nloc; b.st[1] = nx; }
        const unsigned old = xb_add(&bar[XB_XSUB(b.x)], 1u);
        const unsigned gen = old / nloc;
        if (old + 1u == (gen + 1u) * nloc) {
            __builtin_amdgcn_fence(__ATOMIC_RELEASE, "agent");
            asm volatile("s_waitcnt vmcnt(0)" ::: "memory");
            const unsigned og = xb_add(&bar[XB_TOP], 1u);
            const unsigned tg = og / nx;
            if (og + 1u == (tg + 1u) * nx) xb_add(&bar[XB_TOPGEN], 1u);
            else XB_SPIN(xb_ld(&bar[XB_TOPGEN]) == tg, bar);
            __builtin_amdgcn_fence(__ATOMIC_ACQUIRE, "agent");
            xb_add(&bar[XB_XGEN(b.x)], 1u);
            asm volatile("s_waitcnt vmcnt(0)" ::: "memory");
        } else {
            XB_SPIN(xb_ld(&bar[XB_XGEN(b.x)]) == gen, bar);
            __builtin_amdgcn_fence(__ATOMIC_ACQUIRE, "agent");
            asm volatile("s_waitcnt vmcnt(0)" ::: "memory");
        }
    }
    __syncthreads();
}


#ifndef GEMM_SP2
#define GEMM_SP2 true
#endif
#ifndef GEMM_ALIGN
#define GEMM_ALIGN true
#endif
__global__ void __launch_bounds__(NTHREADS, 2) fwd_megakernel(Params p) {
    extern __shared__ __attribute__((aligned(16))) unsigned char lds_raw[];
    LAS unsigned char* lds = (LAS unsigned char*)lds_raw;
    cg::grid_group grid = cg::this_grid();
    if (threadIdx.x < 4) ((LAS unsigned*)(lds + LDS_BYTES - 16))[threadIdx.x] = 0u;
    __syncthreads();
    XcdBarrier xbar = xcd_barrier_post((unsigned*)p.ws, (volatile LAS unsigned*)(lds + LDS_BYTES - 16));
    bf16* const wt_in = (bf16*)(p.ws + WS_WIN); bf16* const wt_out = (bf16*)(p.ws + WS_WOUT); bf16* const wt_up = (bf16*)(p.ws + WS_WUP); bf16* const wt_dn = (bf16*)(p.ws + WS_WDN);
    float* const car = (float*)(p.ws + WS_CAR); bf16* const A0 = (bf16*)(p.ws + WS_A0); bf16* const Pb = (bf16*)(p.ws + WS_B); bf16* const Yb = (bf16*)(p.ws + WS_Y);
    bf16* const Ub = (bf16*)(p.ws + WS_B); bf16* const YBb = (bf16*)(p.ws + WS_C); bf16* const HLb = (bf16*)(p.ws + WS_C + 32 * MiB);
    bf16* const Ab = (bf16*)(p.ws + WS_C);
    bf16* const XBa = (bf16*)p.out;
    bf16* const XBb = (bf16*)(p.ws + WS_B + 64 * MiB);
    const int lo = p.ph_lo, hi = p.ph_hi; int ph = 0;
#define PHASE_BEGIN if (ph >= lo && ph < hi) {
#define PHASE_END   if (ph + 1 < hi) { if (hi < 0) grid.sync(); else xcd_barrier(xbar); } } ++ph;
    PHASE_BEGIN
        convert_layer(p, 0, lds);
        norm0_phase(p.x, p.norm_gains, A0);
    PHASE_END
#pragma unroll 1
    for (int l = 0; l < 2; ++l) {
        PHASE_BEGIN
            pg8::Gemm g{A0, wt_in, T, NIN, D}; pg8::StaticOrder So; So.init(T, NIN, (int)gridDim.x, (int)blockIdx.x); pg8::EpiBf16 E{Pb, NIN, 2};
            pg8::gemm_phase<pg8::EpiBf16, pg8::StaticOrder, GEMM_ALIGN, GEMM_SP2>(lds, g, So, E);
        PHASE_END
        PHASE_BEGIN
            for (int u = blockIdx.x; u < 2304; u += gridDim.x) {
                const int xcd = u & 7, loc = (u >> 3) & 31, rnd = (u >> 8) & 3;
                if (u < 1024) { const int sel = loc >> 4, hb = rnd * 2 + sel; df_unit(p, l, Pb, Yb, (xcd * 16 + (loc & 15)) | ((hb & 3) << 7) | ((hb >> 2) << 9), lds); }
                else if (u < 2048) sb_unit(Pb, Yb, (xcd * 32 + loc) | ((rnd & 1) << 8) | ((rnd >> 1) << 9), lds);
                else lru1_unit(p, l, Pb, HLb, YBb, car, u - 2048, lds);
                __syncthreads();
            }
        PHASE_END
        PHASE_BEGIN
            for (int u = blockIdx.x; u < 1280; u += gridDim.x) {
                if (u < 256) lru3_unit(Pb, Yb, HLb, YBb, car, u, lds);
                else sc_unit(Pb, Yb, p.sc_conv_w + l * 3 * 512, u - 256);
            }
        PHASE_END
        PHASE_BEGIN
            pg8::Gemm g{Yb, wt_out, T, D, D}; pg8::StaticOrder So; So.init(T, D, (int)gridDim.x, (int)blockIdx.x); pg8::EpiBf16 E{A0, D, 0};
            pg8::gemm_phase<pg8::EpiBf16, pg8::StaticOrder, GEMM_ALIGN, GEMM_SP2>(lds, g, So, E);
        PHASE_END
        PHASE_BEGIN
            if (l == 0) normres_phase<false, true>(A0, p.x, XBb, p.norm_gains + (l * 4 + 1) * D, p.norm_gains + (l * 4 + 2) * D);
            else normres_phase<true, true>(A0, XBa, XBb, p.norm_gains + (l * 4 + 1) * D, p.norm_gains + (l * 4 + 2) * D);
        PHASE_END
        PHASE_BEGIN
            pg8::Gemm g{A0, wt_up, T, NUP, D}; pg8::StaticOrder So; So.init(T, NUP, (int)gridDim.x, (int)blockIdx.x); pg8::EpiGeglu E{Ab, Ub, p.ffn_conv_w + (size_t)l * 3 * NUP};
            pg8::gemm_phase<pg8::EpiGeglu, pg8::StaticOrder, GEMM_ALIGN, GEMM_SP2>(lds, g, So, E);
        PHASE_END
        PHASE_BEGIN
            geglu_fix_phase(Ub, Ab, p.ffn_conv_w + (size_t)l * 3 * NUP);
        PHASE_END
        PHASE_BEGIN
            pg8::Gemm g{Ab, wt_dn, T, D, DFF}; pg8::StaticOrder So; So.init(T, D, (int)gridDim.x, (int)blockIdx.x); pg8::EpiBf16 E{A0, D, 0};
            pg8::gemm_phase<pg8::EpiBf16, pg8::StaticOrder, GEMM_ALIGN, GEMM_SP2>(lds, g, So, E);
        PHASE_END
        PHASE_BEGIN
            if (l == 0) normres_phase<true, true>(A0, XBb, XBa, p.norm_gains + (l * 4 + 3) * D, p.norm_gains + 4 * D);
            else normres_phase<true, false>(A0, XBb, p.out, p.norm_gains + (l * 4 + 3) * D, nullptr);
            if (l == 0) convert_layer(p, 1, lds);
        PHASE_END
    }
}

extern "C" void kernel_launch(void* const* d_in, const int* in_sizes, int n_in, void* d_out, int out_size, void* d_ws, size_t ws_size, hipStream_t stream) {
    static int grid = 0;
    if (grid == 0) {
        if (n_in != 16 || out_size != T * D || ws_size < WS_END) { fprintf(stderr, "kernel_launch: unexpected shapes (n_in %d out %d ws %zu)\n", n_in, out_size, ws_size); grid = -1; return; }
        int dev = 0, cus = 0, per_cu = 0;
        hipGetDevice(&dev); hipDeviceGetAttribute(&cus, hipDeviceAttributeMultiprocessorCount, dev);
        if (hipFuncSetAttribute((const void*)fwd_megakernel, hipFuncAttributeMaxDynamicSharedMemorySize, LDS_BYTES) != hipSuccess) { fprintf(stderr, "kernel_launch: hipFuncSetAttribute failed\n"); grid = -1; return; }
        if (hipOccupancyMaxActiveBlocksPerMultiprocessor(&per_cu, (const void*)fwd_megakernel, NTHREADS, LDS_BYTES) != hipSuccess || per_cu < 1) { fprintf(stderr, "kernel_launch: occupancy query failed (%d)\n", per_cu); per_cu = 1; }
        (void)hipGetLastError();
        grid = cus * per_cu;
    }
    if (grid < 0) return;
    Params p{};
    p.x = (const float*)d_in[0]; p.norm_gains = (const float*)d_in[1]; p.w_in = (const float*)d_in[2]; p.w_out = (const float*)d_in[3]; p.rel_bias = (const float*)d_in[4];
    p.diff_lambda = (const float*)d_in[5]; p.diff_subln_g = (const float*)d_in[6]; p.lru_conv_w = (const float*)d_in[7]; p.lru_conv_b = (const float*)d_in[8];
    p.lru_w_gate = (const float*)d_in[9]; p.lru_b_gate = (const float*)d_in[10]; p.lru_lambda = (const float*)d_in[11]; p.sc_conv_w = (const float*)d_in[12];
    p.ffn_w_up = (const float*)d_in[13]; p.ffn_conv_w = (const float*)d_in[14]; p.ffn_w_down = (const float*)d_in[15];
    p.out = (float*)d_out; p.ws = (unsigned char*)d_ws; p.ph_lo = 0; p.ph_hi = 1000;
    if (hipMemsetAsync(d_ws, 0, 16384, stream) != hipSuccess) { fprintf(stderr, "kernel_launch: memset of the barrier words failed\n"); return; }
    void* args[] = {&p};
    hipError_t e = hipLaunchCooperativeKernel((const void*)fwd_megakernel, dim3(grid), dim3(NTHREADS), args, LDS_BYTES, stream);
    if (e != hipSuccess) fprintf(stderr, "kernel_launch: cooperative launch failed: %s (grid %d)\n", hipGetErrorString(e), grid);
}
```
